# Optimizing an MI355X kernel written in HIP

```python
import math
import jax, jax.numpy as jnp
from jax import lax
import numpy as np

D_MODEL = 1024
BATCH = 4
SEQ = 4096
DEPTH = 1

D_MIX = D_MODEL
ATTN_WIDTH = D_MIX // 2
CONV_WIDTH = D_MIX - ATTN_WIDTH
N_ATTN_HEADS = 4
ATTN_HEAD_DIM = ATTN_WIDTH // (2 * N_ATTN_HEADS)
CONV_GROUPS = 8
CONV_WIDTH_K = 3
PLE_DIM = 256
Q_BLOCK = 128
EPS = 1e-6
N_IN_COLS = 4 * ATTN_WIDTH + 4 * CONV_WIDTH

kernel_name = "hybrid_diffattn_shortconv_parallel_block"


def rmsnorm(x, g, eps=EPS):
    xf = x.astype(jnp.float32)
    y = xf * lax.rsqrt(jnp.mean(xf * xf, axis=-1, keepdims=True) + eps)
    return (y * g.astype(jnp.float32)).astype(x.dtype)


def alibi_slopes(n_heads):
    h = jnp.arange(1, n_heads + 1, dtype=jnp.float32)
    return jnp.exp2(-8.0 * h / n_heads)


def diff_attention(q1, q2, k1, k2, v, lam):
    b, n_h, s, d = q1.shape
    dv = v.shape[-1]
    n_blk = s // Q_BLOCK
    scale = d ** -0.5
    slopes = alibi_slopes(n_h)
    kpos = jnp.arange(s, dtype=jnp.int32)
    q1b = q1.reshape(b, n_h, n_blk, Q_BLOCK, d).transpose(2, 0, 1, 3, 4)
    q2b = q2.reshape(b, n_h, n_blk, Q_BLOCK, d).transpose(2, 0, 1, 3, 4)
    starts = jnp.arange(n_blk, dtype=jnp.int32) * Q_BLOCK

    def one_block(args):
        q1_blk, q2_blk, start = args
        qpos = start + jnp.arange(Q_BLOCK, dtype=jnp.int32)
        dist = jnp.abs(qpos[:, None] - kpos[None, :]).astype(jnp.float32)
        bias = -slopes[:, None, None] * dist[None]
        s1 = jnp.einsum('bhqd,bhkd->bhqk', q1_blk, k1).astype(jnp.float32) * scale + bias
        s2 = jnp.einsum('bhqd,bhkd->bhqk', q2_blk, k2).astype(jnp.float32) * scale + bias
        probs = jax.nn.softmax(s1, axis=-1) - lam * jax.nn.softmax(s2, axis=-1)
        return jnp.einsum('bhqk,bhkv->bhqv', probs.astype(v.dtype), v)

    o = lax.map(one_block, (q1b, q2b, starts))
    return o.transpose(1, 0, 3, 2, 4).reshape(b, s, n_h, dv)


def depthwise_conv3(u, w):
    c = u.shape[-1]
    rhs = w.astype(u.dtype)[:, None, :]
    pad = (CONV_WIDTH_K - 1) // 2
    return lax.conv_general_dilated(
        u, rhs, window_strides=(1,), padding=((pad, pad),),
        dimension_numbers=('NWC', 'WIO', 'NWC'), feature_group_count=c)


def setup_inputs(seed: int = 0) -> dict:
    key = jax.random.key(seed)
    ks = jax.random.split(key, 16)
    f32 = jnp.float32
    d = ATTN_HEAD_DIM
    x = jax.random.normal(ks[0], (BATCH, SEQ, D_MODEL), f32)
    p = jax.random.normal(ks[1], (DEPTH, BATCH, SEQ, PLE_DIM), f32)
    mix_norm_g = 1.0 + 0.02 * jax.random.normal(ks[2], (DEPTH, D_MODEL), f32)
    w_in = jax.random.normal(ks[3], (DEPTH, D_MODEL, N_IN_COLS), f32) * D_MODEL ** -0.5
    lambda_q1 = 0.1 * jax.random.normal(ks[4], (DEPTH, d), f32)
    lambda_k1 = 0.1 * jax.random.normal(ks[5], (DEPTH, d), f32)
    lambda_q2 = 0.1 * jax.random.normal(ks[6], (DEPTH, d), f32)
    lambda_k2 = 0.1 * jax.random.normal(ks[7], (DEPTH, d), f32)
    subln_g = 1.0 + 0.02 * jax.random.normal(ks[8], (DEPTH, 2 * d), f32)
    conv_w = jax.random.normal(ks[9], (DEPTH, CONV_WIDTH_K, CONV_WIDTH), f32) * CONV_WIDTH_K ** -0.5
    w_out = jax.random.normal(ks[10], (DEPTH, D_MIX, D_MODEL), f32) * D_MIX ** -0.5
    ple_norm_g = 1.0 + 0.02 * jax.random.normal(ks[11], (DEPTH, D_MODEL), f32)
    w_ple_gate = jax.random.normal(ks[12], (DEPTH, D_MODEL, D_MODEL), f32) * D_MODEL ** -0.5
    w_ple_proj = jax.random.normal(ks[13], (DEPTH, PLE_DIM, D_MODEL), f32) * PLE_DIM ** -0.5
    final_norm_g = 1.0 + 0.02 * jax.random.normal(ks[14], (D_MODEL,), f32)
    return {"x": x, "p": p, "mix_norm_g": mix_norm_g, "w_in": w_in,
            "lambda_q1": lambda_q1, "lambda_k1": lambda_k1,
            "lambda_q2": lambda_q2, "lambda_k2": lambda_k2,
            "subln_g": subln_g, "conv_w": conv_w, "w_out": w_out,
            "ple_norm_g": ple_norm_g, "w_ple_gate": w_ple_gate,
            "w_ple_proj": w_ple_proj, "final_norm_g": final_norm_g}


def reference(x, p, mix_norm_g, w_in, lambda_q1, lambda_k1, lambda_q2, lambda_k2,
              subln_g, conv_w, w_out, ple_norm_g, w_ple_gate, w_ple_proj, final_norm_g):
    b, s, _ = x.shape
    n_h, d = N_ATTN_HEADS, ATTN_HEAD_DIM
    split_at = [ATTN_WIDTH, 2 * ATTN_WIDTH, 3 * ATTN_WIDTH, 4 * ATTN_WIDTH,
                4 * ATTN_WIDTH + CONV_WIDTH, 4 * ATTN_WIDTH + 2 * CONV_WIDTH,
                4 * ATTN_WIDTH + 3 * CONV_WIDTH]
    for i in range(DEPTH):
        lambda_init = 0.8 - 0.6 * math.exp(-0.3 * i)
        h = rmsnorm(x, mix_norm_g[i])
        z = h @ w_in[i]
        q, k, v, g_attn, cb, cc, ch, g_conv = jnp.split(z, split_at, axis=-1)

        q = q.reshape(b, s, n_h, 2, d).transpose(0, 2, 3, 1, 4)
        k = k.reshape(b, s, n_h, 2, d).transpose(0, 2, 3, 1, 4)
        vh = v.reshape(b, s, n_h, 2 * d).transpose(0, 2, 1, 3)
        lam = (jnp.exp(jnp.sum(lambda_q1[i].astype(jnp.float32) * lambda_k1[i].astype(jnp.float32)))
               - jnp.exp(jnp.sum(lambda_q2[i].astype(jnp.float32) * lambda_k2[i].astype(jnp.float32)))
               + lambda_init)
        o_attn = diff_attention(q[:, :, 0], q[:, :, 1], k[:, :, 0], k[:, :, 1], vh, lam)
        o_attn = rmsnorm(o_attn, subln_g[i]) * (1.0 - lambda_init)
        o_attn = o_attn.reshape(b, s, ATTN_WIDTH) * jax.nn.silu(g_attn)

        o_conv = cb * depthwise_conv3(cc * ch, conv_w[i]) * jax.nn.silu(g_conv)

        x = x + jnp.concatenate([o_attn, o_conv], axis=-1) @ w_out[i]

        gate = jax.nn.sigmoid(rmsnorm(x, ple_norm_g[i]) @ w_ple_gate[i])
        x = x + gate * (p[i] @ w_ple_proj[i])
    return rmsnorm(x, final_norm_g)
```

```cpp
#include <hip/hip_runtime.h>
#include <hip/hip_cooperative_groups.h>
#include <cstdio>
#include <cstdint>
namespace cg = cooperative_groups;

#ifndef MK_ONE_LAUNCH
#define MK_ONE_LAUNCH 1
#endif

#ifndef REP_MASK
#define REP_MASK 0
#endif
#define LAS __attribute__((address_space(3)))
typedef unsigned short bf16_t;
typedef short bf16x8 __attribute__((ext_vector_type(8)));
typedef short s16x4 __attribute__((ext_vector_type(4)));
typedef float f32x4 __attribute__((ext_vector_type(4)));
typedef float f32x8 __attribute__((ext_vector_type(8)));
typedef float f32x16 __attribute__((ext_vector_type(16)));
typedef unsigned u32x4 __attribute__((ext_vector_type(4)));
typedef unsigned u32x2 __attribute__((ext_vector_type(2)));

constexpr int DM = 1024, NB = 4, SEQ = 4096, MTOK = NB * SEQ, NIN = 4096, PLE = 256, NH = 4;
constexpr float EPS = 1e-6f;
constexpr int NTHREADS = 512;
constexpr int LDS_STAGE = 131072;
constexpr int LDS_BYTES = LDS_STAGE + 64;

constexpr size_t MiB = 1024 * 1024;
constexpr size_t WS_XB = 0;
constexpr size_t WS_WIN = WS_XB + 32 * MiB;
constexpr size_t WS_WOUT = WS_WIN + 8 * MiB;
constexpr size_t WS_WG = WS_WOUT + 2 * MiB;
constexpr size_t WS_WP = WS_WG + 2 * MiB;
constexpr size_t WS_PB = WS_WP + 1 * MiB;
constexpr size_t WS_Z = WS_PB + 8 * MiB;
constexpr size_t WS_AO = WS_Z + 128 * MiB;
constexpr size_t WS_RSTD1 = WS_AO + 64 * MiB;
constexpr size_t WS_RSQ2 = WS_RSTD1 + 65536;
constexpr size_t WS_RSQ3 = WS_RSQ2 + 1 * MiB;
constexpr size_t WS_BAR = WS_RSQ3 + 1 * MiB;
constexpr size_t WS_KSQ = WS_BAR + 32768;
constexpr size_t WS_CNT = WS_BAR + 16384;
constexpr size_t WS_END = WS_KSQ + (size_t)MTOK * 8 * 4;

struct Params {
    const float* x; const float* p; const float* g1; const float* w_in;
    const float* lq1; const float* lk1; const float* lq2; const float* lk2;
    const float* subln_g; const float* conv_w; const float* w_out; const float* g2;
    const float* w_g; const float* w_p; const float* gf;
    float* out; unsigned char* ws;
    int ph_lo, ph_hi, use_cg, pad;
};

__device__ __forceinline__ unsigned cvt_pk_bf16(float lo, float hi) { unsigned r; asm volatile("v_cvt_pk_bf16_f32 %0, %1, %2" : "=v"(r) : "v"(lo), "v"(hi)); return r; }
__device__ __forceinline__ float bf_lo(unsigned w) { return __uint_as_float(w << 16); }
__device__ __forceinline__ float bf_hi(unsigned w) { return __uint_as_float(w & 0xffff0000u); }
__device__ __forceinline__ float silu_f(float v) { return v * __builtin_amdgcn_rcpf(1.f + __expf(-v)); }
__device__ __forceinline__ float sigmoid_f(float v) { return __builtin_amdgcn_rcpf(1.f + __expf(-v)); }
__device__ __forceinline__ float wave_sum(float v) {
#pragma unroll
    for (int o = 32; o >= 1; o >>= 1) v += __shfl_xor(v, o);
    return v;
}


#define XB_TMO      128
#define XB_XCNT(j)  (256  + 64 * (j))
#define XB_XSUB(j)  (1280 + 64 * (j))
#define XB_XGEN(j)  (2304 + 64 * (j))
#define XB_TOP      3328
#define XB_TOPGEN   3392
#define XCD_BAR_WORDS 3456
#define XB_SPIN_CAP (1u << 20)
__device__ __forceinline__ unsigned xb_ld(unsigned* p)              { return __hip_atomic_load(p, __ATOMIC_RELAXED, __HIP_MEMORY_SCOPE_AGENT); }
__device__ __forceinline__ unsigned xb_add(unsigned* p, unsigned v) { return __hip_atomic_fetch_add(p, v, __ATOMIC_RELAXED, __HIP_MEMORY_SCOPE_AGENT); }
__device__ __forceinline__ unsigned xb_xcc_id() { return (unsigned)__builtin_amdgcn_s_getreg((3 << 11) | 20) & 0xFu; }
#define XB_SPIN(cond, bar) do { unsigned _sp = 0; while (cond) { __builtin_amdgcn_s_sleep(1); \
    if ((++_sp & 255u) == 0u) { if (xb_ld(&(bar)[XB_TMO])) break; if (_sp > XB_SPIN_CAP) { atomicAdd(&(bar)[XB_TMO], 1u); break; } } } } while (0)
struct XcdBarrier { unsigned* bar; unsigned x; volatile LAS unsigned* st; };
__device__ __forceinline__ XcdBarrier xcd_barrier_post(unsigned* bar, volatile LAS unsigned* st) {
    XcdBarrier b; b.bar = bar; b.x = xb_xcc_id(); b.st = st;
    if (threadIdx.x == 0) (void)xb_add(&bar[XB_XCNT(b.x)], 1u);
    return b;
}
__device__ __forceinline__ void xcd_barrier_complete(unsigned* bar, unsigned x, unsigned& nloc, unsigned& nx) {
    const unsigned G = gridDim.x * gridDim.y * gridDim.z;
    unsigned sum, cnt, mine, sp = 0u;
    for (;;) {
        sum = 0u; cnt = 0u; mine = 0u;
#pragma unroll
        for (unsigned j = 0; j < 16; ++j) { const unsigned c = xb_ld(&bar[XB_XCNT(j)]); sum += c; cnt += (c > 0u) ? 1u : 0u; mine = (j == x) ? c : mine; }
        if (sum == G) break;
        __builtin_amdgcn_s_sleep(1);
        if ((++sp & 255u) == 0u) { if (xb_ld(&bar[XB_TMO])) break; if (sp > XB_SPIN_CAP) { atomicAdd(&bar[XB_TMO], 1u); break; } }
    }
    nloc = mine > 0u ? mine : 1u; nx = cnt > 0u ? cnt : 1u;
}
__device__ __forceinline__ void xcd_barrier(const XcdBarrier& b) {
    asm volatile("s_waitcnt vmcnt(0)" ::: "memory");
    __syncthreads();
    if (threadIdx.x == 0) {
        unsigned* bar = b.bar;
        __builtin_amdgcn_s_waitcnt(0);
        unsigned nloc = b.st[0], nx = b.st[1];
        if (nloc == 0u) { xcd_barrier_complete(bar, b.x, nloc, nx); b.st[0] = nloc; b.st[1] = nx; }
        const unsigned old = xb_add(&bar[XB_XSUB(b.x)], 1u);
        const unsigned gen = old / nloc;
        if (old + 1u == (gen + 1u) * nloc) {
            __builtin_amdgcn_fence(__ATOMIC_RELEASE, "agent");
            asm volatile("s_waitcnt vmcnt(0)" ::: "memory");
            const unsigned og = xb_add(&bar[XB_TOP], 1u);
            const unsigned tg = og / nx;
            if (og + 1u == (tg + 1u) * nx) xb_add(&bar[XB_TOPGEN], 1u);
            else XB_SPIN(xb_ld(&bar[XB_TOPGEN]) == tg, bar);
            __builtin_amdgcn_fence(__ATOMIC_ACQUIRE, "agent");
            xb_add(&bar[XB_XGEN(b.x)], 1u);
            asm volatile("s_waitcnt vmcnt(0)" ::: "memory");
        } else {
            XB_SPIN(xb_ld(&bar[XB_XGEN(b.x)]) == gen, bar);
            __builtin_amdgcn_fence(__ATOMIC_ACQUIRE, "agent");
            asm volatile("s_waitcnt vmcnt(0)" ::: "memory");
        }
    }
    __syncthreads();
}

namespace pg8 {
constexpr int BM = 256, BK = 64, HALF = 128, HTB = HALF * BK * 2, STAGE_BYTES = 8 * HTB, NXCD = 8, WGM = 8;
__host__ __device__ __forceinline__ int lds_byte(int r, int c) { const int st = (r >> 4) * 2 + (c >> 5), rr = r & 15, cc = c & 31, ob = rr * 64 + cc * 2; return st * 1024 + (ob ^ (((ob >> 9) & 1) << 5)); }
__host__ __device__ __forceinline__ void stage_rc(int b, int& R, int& C) { const int st = b / 1024, sb = b % 1024, swz = sb ^ (((sb >> 9) & 1) << 5); R = (st >> 1) * 16 + swz / 64; C = (st & 1) * 32 + (swz % 64) / 2; }
__host__ __device__ __forceinline__ int perm32(int rho) { const int n = rho >> 4, i = rho & 15; return 8 * (i >> 2) + 4 * n + (i & 3); }
struct Unit { int pm, pn; };
struct Gemm { const bf16_t* A; const bf16_t* Bt; int M, N, K; };
struct StaticOrder {
    int nM, nN, nwg, G, c;
    __device__ void init(int M, int N, int G_, int c_) { nM = M / BM; nN = N / BM; nwg = nM * nN; G = G_; c = c_; }
    __device__ bool next(int i, Unit& u) const {
        const long L = (long)i * G + c; if (L >= nwg) return false;
        int wgid = (int)L; { const int q = nwg / NXCD, r = nwg % NXCD, xcd = wgid % NXCD, off = wgid / NXCD; wgid = (xcd < r ? xcd * (q + 1) : r * (q + 1) + (xcd - r) * q) + off; }
        const int nig = WGM * nN, gid = wgid / nig, fm = gid * WGM, gsz = (nM - fm) < WGM ? (nM - fm) : WGM;
        u.pm = fm + ((wgid % nig) % gsz); u.pn = (wgid % nig) / gsz; return true;
    }
};
template <class Epi>
__device__ __forceinline__ void gemm_phase(LAS unsigned char* lds, const Gemm g, const StaticOrder& S, const Epi& E) {
    const int tid = threadIdx.x, wid = __builtin_amdgcn_readfirstlane(tid >> 6), lane = tid & 63, wr = wid >> 2, wc = wid & 3, fr = lane & 15, fq = lane >> 4;
    const int K = g.K, nt = K / BK;
    unsigned voffA[2], voffB[2];
#pragma unroll
    for (int i = 0; i < 2; ++i) { int R, C; stage_rc(tid * 16 + i * 8192, R, C); const int Rb = Epi::PERM ? ((R & ~31) + perm32(R & 31)) : R;
        voffA[i] = (unsigned)(R * K + C) * 2u; voffB[i] = (unsigned)(Rb * K + C) * 2u; }
    const size_t kstep = (size_t)(BK * 2);
    const size_t hstep = (size_t)HALF * K * 2;
    const size_t tstep = 2 * hstep;
    const unsigned ldsw = (unsigned)wid * 1024u;
    const int aoff = lds_byte(wr * 64 + fr, fq * 8), boff = lds_byte(wc * 32 + fr, fq * 8);
#define PG8_SA(b, h) (((b) * 2 + (h)) * HTB)
#define PG8_SB(b, h) ((4 + (b) * 2 + (h)) * HTB)
#define PG8_STAGE(bufoff, gbase, voff) do { _Pragma("unroll") for (int _i = 0; _i < 2; ++_i) \
        __builtin_amdgcn_global_load_lds((const unsigned*)((const char*)(gbase) + (voff)[_i]), (LAS unsigned*)(lds + (bufoff) + ldsw + _i * 8192), 16, 0, 0); } while (0)
#define PG8_LDA(dst, b, h) do { _Pragma("unroll") for (int m = 0; m < 4; ++m) _Pragma("unroll") for (int k = 0; k < 2; ++k) dst[m][k] = *(const LAS bf16x8*)(lds + PG8_SA(b, h) + aoff + m * 2048 + k * 1024); } while (0)
#define PG8_LDB(dst, b, h) do { _Pragma("unroll") for (int n = 0; n < 2; ++n) _Pragma("unroll") for (int k = 0; k < 2; ++k) dst[n][k] = *(const LAS bf16x8*)(lds + PG8_SB(b, h) + boff + n * 2048 + k * 1024); } while (0)
#define PG8_MMA(ai, bj, At, Bt) do { __builtin_amdgcn_s_setprio(1); _Pragma("unroll") for (int m = 0; m < 4; ++m) _Pragma("unroll") for (int n = 0; n < 2; ++n) _Pragma("unroll") for (int k = 0; k < 2; ++k) \
        acc[ai][bj][m][n] = __builtin_amdgcn_mfma_f32_16x16x32_bf16(Bt[n][k], At[m][k], acc[ai][bj][m][n], 0, 0, 0); __builtin_amdgcn_s_setprio(0); } while (0)
#define PG8_WAIT_V(n) asm volatile("s_waitcnt vmcnt(" #n ")" ::: "memory")
#define PG8_WAIT_L(n) asm volatile("s_waitcnt lgkmcnt(" #n ")" ::: "memory")
#define PG8_BAR __builtin_amdgcn_s_barrier()
#define PG8_SCHED __builtin_amdgcn_sched_barrier(0)
    Unit cur, nxt; int ui = 0;
    if (!S.next(0, cur)) return;
    f32x4 acc[2][2][4][2];
#pragma unroll
    for (int a = 0; a < 2; ++a)
#pragma unroll
        for (int b = 0; b < 2; ++b)
#pragma unroll
            for (int m = 0; m < 4; ++m)
#pragma unroll
                for (int n = 0; n < 2; ++n) acc[a][b][m][n] = (f32x4){0.f, 0.f, 0.f, 0.f};
    bf16x8 At[4][2], B0[2][2], B1[2][2];
    const char* cA = (const char*)g.A + (size_t)cur.pm * tstep; const char* cB = (const char*)g.Bt + (size_t)cur.pn * tstep;
    PG8_STAGE(PG8_SB(0, 0), cB, voffB); PG8_STAGE(PG8_SA(0, 0), cA, voffA); PG8_STAGE(PG8_SB(0, 1), cB + hstep, voffB); PG8_STAGE(PG8_SA(0, 1), cA + hstep, voffA);
    if (wr == 1) PG8_BAR;
    PG8_WAIT_V(4); PG8_BAR;
    PG8_STAGE(PG8_SB(1, 0), cB + kstep, voffB); PG8_STAGE(PG8_SA(1, 0), cA + kstep, voffA); PG8_STAGE(PG8_SB(1, 1), cB + hstep + kstep, voffB);
    PG8_WAIT_V(6); PG8_BAR;
    for (;;) {
        const bool has_next = S.next(ui + 1, nxt);
        const char* nA = has_next ? (const char*)g.A + (size_t)nxt.pm * tstep : cA; const char* nB = has_next ? (const char*)g.Bt + (size_t)nxt.pn * tstep : cB;
        for (int t = 0; t < nt; t += 2) {
            const bool last = (t == nt - 2);
            const char* a1 = cA + (size_t)(t + 1) * kstep;
            const char* a2 = last ? nA : cA + (size_t)(t + 2) * kstep; const char* b2 = last ? nB : cB + (size_t)(t + 2) * kstep;
            const char* a3 = a2 + kstep; const char* b3 = b2 + kstep;
            PG8_LDB(B0, 0, 0); PG8_SCHED; PG8_LDA(At, 0, 0); PG8_STAGE(PG8_SA(1, 1), a1 + hstep, voffA);
            PG8_WAIT_L(8); PG8_BAR; PG8_WAIT_L(0); PG8_MMA(0, 0, At, B0); PG8_BAR; PG8_SCHED;
            PG8_LDB(B1, 0, 1); PG8_STAGE(PG8_SB(0, 0), b2, voffB);
            PG8_BAR; PG8_WAIT_L(0); PG8_MMA(0, 1, At, B1); PG8_BAR;
            PG8_LDA(At, 0, 1); PG8_STAGE(PG8_SA(0, 0), a2, voffA);
            PG8_BAR; PG8_WAIT_L(0); PG8_MMA(1, 0, At, B0); PG8_BAR; PG8_SCHED;
            PG8_STAGE(PG8_SB(0, 1), b2 + hstep, voffB);
            PG8_WAIT_V(6); PG8_BAR; PG8_MMA(1, 1, At, B1); PG8_BAR;
            PG8_LDB(B0, 1, 0); PG8_SCHED; PG8_LDA(At, 1, 0); PG8_STAGE(PG8_SA(0, 1), a2 + hstep, voffA);
            PG8_WAIT_L(8); PG8_BAR; PG8_WAIT_L(0); PG8_MMA(0, 0, At, B0); PG8_BAR; PG8_SCHED;
            PG8_LDB(B1, 1, 1); PG8_STAGE(PG8_SB(1, 0), b3, voffB);
            PG8_BAR; PG8_WAIT_L(0); PG8_MMA(0, 1, At, B1); PG8_BAR;
            PG8_LDA(At, 1, 1); PG8_STAGE(PG8_SA(1, 0), a3, voffA);
            PG8_BAR; PG8_WAIT_L(0); PG8_MMA(1, 0, At, B0); PG8_BAR; PG8_SCHED;
            PG8_STAGE(PG8_SB(1, 1), b3 + hstep, voffB);
            PG8_WAIT_V(6); PG8_BAR; PG8_MMA(1, 1, At, B1); PG8_BAR;
        }
        if constexpr (!Epi::AFTER_DRAIN) E(acc, cur, wr, wc, fr, fq);
        if (!has_next) break;
#pragma unroll
        for (int a = 0; a < 2; ++a)
#pragma unroll
            for (int b = 0; b < 2; ++b)
#pragma unroll
                for (int m = 0; m < 4; ++m)
#pragma unroll
                    for (int n = 0; n < 2; ++n) acc[a][b][m][n] = (f32x4){0.f, 0.f, 0.f, 0.f};
        cur = nxt; cA = nA; cB = nB; ++ui;
    }
    PG8_WAIT_V(0);
    if (wr == 0) PG8_BAR;
    PG8_BAR;
    if constexpr (Epi::AFTER_DRAIN) E.fused(acc, cur, wr, wc, fr, fq);
#undef PG8_SA
#undef PG8_SB
#undef PG8_STAGE
#undef PG8_LDA
#undef PG8_LDB
#undef PG8_MMA
#undef PG8_WAIT_V
#undef PG8_WAIT_L
#undef PG8_BAR
#undef PG8_SCHED
}

struct EpiZ {
    static constexpr bool PERM = true, AFTER_DRAIN = false;
    bf16_t* Z; const float* rstd; int ldz; float* ksq;
    __device__ __forceinline__ void operator()(const f32x4 (&acc)[2][2][4][2], const Unit& u, int wr, int wc, int fr, int fq) const {
        const int row0 = u.pm * BM + wr * 64 + fr, col0 = u.pn * BM + wc * 32 + 8 * fq;
        const bool kcols = ksq != nullptr && (u.pn >> 1) == 1;
        if (ksq != nullptr && u.pn >= 8) {
            const int q = u.pn - 8, chn0 = 128 * (q & 3) + 32 * wc + 8 * fq;
            bf16_t* base = Z + (q < 4 ? 2048 : 2560) + chn0;
#pragma unroll
            for (int ai = 0; ai < 2; ++ai)
#pragma unroll
                for (int m = 0; m < 4; ++m) { const int row = row0 + ai * HALF + m * 16;
                    const f32x4 a0 = acc[ai][0][m][0], a1 = acc[ai][0][m][1]; f32x4 b0 = acc[ai][1][m][0], b1 = acc[ai][1][m][1];
                    if (q >= 4) {
#pragma unroll
                        for (int i = 0; i < 4; ++i) { b0[i] = silu_f(b0[i]); b1[i] = silu_f(b1[i]); } }
                    u32x4 w; w.x = cvt_pk_bf16(a0[0] * b0[0], a0[1] * b0[1]); w.y = cvt_pk_bf16(a0[2] * b0[2], a0[3] * b0[3]);
                    w.z = cvt_pk_bf16(a1[0] * b1[0], a1[1] * b1[1]); w.w = cvt_pk_bf16(a1[2] * b1[2], a1[3] * b1[3]);
                    *(u32x4*)(base + (size_t)row * ldz) = w; }
            return;
        }
#pragma unroll
        for (int ai = 0; ai < 2; ++ai)
#pragma unroll
            for (int m = 0; m < 4; ++m) { const int row = row0 + ai * HALF + m * 16; const float rs = rstd ? rstd[row] : 1.f; bf16_t* rowp = Z + (size_t)row * ldz + col0;
#pragma unroll
                for (int bj = 0; bj < 2; ++bj) { const f32x4 v0 = acc[ai][bj][m][0] * rs, v1 = acc[ai][bj][m][1] * rs;
                    u32x4 w; w.x = cvt_pk_bf16(v0[0], v0[1]); w.y = cvt_pk_bf16(v0[2], v0[3]); w.z = cvt_pk_bf16(v1[0], v1[1]); w.w = cvt_pk_bf16(v1[2], v1[3]);
                    *(u32x4*)(rowp + bj * HALF) = w;
                    if (kcols) { float sq = v0[0] * v0[0] + v0[1] * v0[1] + v0[2] * v0[2] + v0[3] * v0[3] + v1[0] * v1[0] + v1[1] * v1[1] + v1[2] * v1[2] + v1[3] * v1[3];
                        sq += __shfl_xor(sq, 16); sq += __shfl_xor(sq, 32);
                        if (fq == 0) unsafeAtomicAdd(ksq + (size_t)row * 8 + (u.pn - 2) * 4 + bj * 2 + (wc >> 1), sq); } } }
    }
};
struct EpiRes {
    static constexpr bool PERM = true, AFTER_DRAIN = false;
    const float* X; float* O; bf16_t* Ob; float* rsq;
    __device__ __forceinline__ void operator()(const f32x4 (&acc)[2][2][4][2], const Unit& u, int wr, int wc, int fr, int fq) const {
        const int row0 = u.pm * BM + wr * 64 + fr, col0 = u.pn * BM + wc * 32 + 8 * fq;
#pragma unroll
        for (int ai = 0; ai < 2; ++ai)
#pragma unroll
            for (int m = 0; m < 4; ++m) { const int row = row0 + ai * HALF + m * 16; const size_t ro = (size_t)row * DM + col0; float ss = 0.f;
#pragma unroll
                for (int bj = 0; bj < 2; ++bj) { const f32x4 x0 = *(const f32x4*)(X + ro + bj * HALF), x1 = *(const f32x4*)(X + ro + bj * HALF + 4);
                    const f32x4 v0 = acc[ai][bj][m][0] + x0, v1 = acc[ai][bj][m][1] + x1;
                    u32x4 w; w.x = cvt_pk_bf16(v0[0], v0[1]); w.y = cvt_pk_bf16(v0[2], v0[3]); w.z = cvt_pk_bf16(v1[0], v1[1]); w.w = cvt_pk_bf16(v1[2], v1[3]);
                    *(u32x4*)(Ob + ro + bj * HALF) = w;
                    const float q0 = bf_lo(w.x), q1 = bf_hi(w.x), q2 = bf_lo(w.y), q3 = bf_hi(w.y), q4 = bf_lo(w.z), q5 = bf_hi(w.z), q6 = bf_lo(w.w), q7 = bf_hi(w.w);
                    ss += (q0 * q0 + q1 * q1 + q2 * q2 + q3 * q3) + (q4 * q4 + q5 * q5 + q6 * q6 + q7 * q7); }
                ss += __shfl_xor(ss, 16); ss += __shfl_xor(ss, 32);
                if (fq == 0) rsq[(size_t)row * 16 + u.pn * 4 + wc] = ss; }
    }
};
struct EpiGateNorm {
    static constexpr bool PERM = false, AFTER_DRAIN = true;
    const bf16_t* X1; float* O; const bf16_t* PP; const float* rsq_in; float* rsq; unsigned* cnt; const float* gf;
    __device__ __forceinline__ void fused(f32x4 (&acc)[2][2][4][2], const Unit& u, int wr, int wc, int fr, int fq) const {
        const int row0 = u.pm * BM + wr * 64 + fr, col0 = u.pn * BM + wc * 32 + 4 * fq;
#pragma unroll
        for (int ai = 0; ai < 2; ++ai)
#pragma unroll
            for (int m = 0; m < 4; ++m) { const int row = row0 + ai * HALF + m * 16; const size_t ro = (size_t)row * DM + col0; float ss = 0.f;
                const f32x4 rq = *(const f32x4*)(rsq_in + (size_t)row * 16 + fq * 4);
                float tot = (rq[0] + rq[1]) + (rq[2] + rq[3]);
                tot += __shfl_xor(tot, 16); tot += __shfl_xor(tot, 32);
                const float rs = __builtin_amdgcn_rsqf(tot * (1.f / DM) + EPS);
#pragma unroll
                for (int bj = 0; bj < 2; ++bj)
#pragma unroll
                    for (int n = 0; n < 2; ++n) { const u32x2 xw = *(const u32x2*)(X1 + ro + bj * HALF + n * 16); const f32x4 xv = {bf_lo(xw.x), bf_hi(xw.x), bf_lo(xw.y), bf_hi(xw.y)}; const u32x2 pw = *(const u32x2*)(PP + ro + bj * HALF + n * 16);
                        const f32x4 a = acc[ai][bj][m][n] * rs; f32x4 v;
                        v[0] = xv[0] + sigmoid_f(a[0]) * bf_lo(pw.x); v[1] = xv[1] + sigmoid_f(a[1]) * bf_hi(pw.x);
                        v[2] = xv[2] + sigmoid_f(a[2]) * bf_lo(pw.y); v[3] = xv[3] + sigmoid_f(a[3]) * bf_hi(pw.y);
                        acc[ai][bj][m][n] = v; ss += v[0] * v[0] + v[1] * v[1] + v[2] * v[2] + v[3] * v[3]; }
                ss += __shfl_xor(ss, 16); ss += __shfl_xor(ss, 32);
                if (fq == 0) __hip_atomic_store(rsq + (size_t)row * 16 + u.pn * 4 + wc, ss, __ATOMIC_RELAXED, __HIP_MEMORY_SCOPE_AGENT); }
        asm volatile("s_waitcnt vmcnt(0)" ::: "memory");
        __syncthreads();
        if (threadIdx.x == 0) {
            __builtin_amdgcn_fence(__ATOMIC_RELEASE, "agent");
            asm volatile("s_waitcnt vmcnt(0)" ::: "memory");
            (void)__hip_atomic_fetch_add(cnt + u.pm * 64, 1u, __ATOMIC_RELAXED, __HIP_MEMORY_SCOPE_AGENT);
            unsigned sp = 0u;
            while (__hip_atomic_load(cnt + u.pm * 64, __ATOMIC_RELAXED, __HIP_MEMORY_SCOPE_AGENT) < 4u) { __builtin_amdgcn_s_sleep(1); if (++sp > (1u << 22)) break; }
            __builtin_amdgcn_fence(__ATOMIC_ACQUIRE, "agent");
            asm volatile("s_waitcnt vmcnt(0)" ::: "memory");
        }
        __syncthreads();
        f32x4 gv[2][2];
#pragma unroll
        for (int bj = 0; bj < 2; ++bj)
#pragma unroll
            for (int n = 0; n < 2; ++n) gv[bj][n] = *(const f32x4*)(gf + col0 + bj * HALF + n * 16);
#pragma unroll
        for (int ai = 0; ai < 2; ++ai)
#pragma unroll
            for (int m = 0; m < 4; ++m) { const int row = row0 + ai * HALF + m * 16; const size_t ro = (size_t)row * DM + col0;
                const f32x4 pq = *(const f32x4*)(rsq + (size_t)row * 16 + fq * 4);
                float tot = (pq[0] + pq[1]) + (pq[2] + pq[3]);
                tot += __shfl_xor(tot, 16); tot += __shfl_xor(tot, 32);
                const float rs = __builtin_amdgcn_rsqf(tot * (1.f / DM) + EPS);
#pragma unroll
                for (int bj = 0; bj < 2; ++bj)
#pragma unroll
                    for (int n = 0; n < 2; ++n) *(f32x4*)(O + ro + bj * HALF + n * 16) = acc[ai][bj][m][n] * rs * gv[bj][n]; }
    }
};
}

namespace att {
constexpr int NW = 8, QBLK = 32, KVBLK = 64, DV = 128, DQ = 64;
constexpr int LDZ = NIN, LDO = 512;
constexpr float SCALE = 0.125f;
constexpr float THR = 8.f;
constexpr size_t SHM_V = KVBLK * DV * 2, SHM_K = KVBLK * DQ * 2;
#define KSWZ(row, colB) ((row) * 128 + ((colB) ^ ((((row) >> 1) & 7) << 4)))
#define SBAR() __builtin_amdgcn_sched_barrier(0)
__device__ __forceinline__ int crow(int r, int hi) { return (r & 3) + 8 * (r >> 2) + 4 * hi; }
constexpr float SKIP_RAW = 40.f / (SCALE * 1.4426950408889634f);
__device__ __forceinline__ bool partialSM(f32x16& p0, f32x16& p1, float off0, float off1, float& m_reg, float& mn, float& alpha) {
    constexpr float C = SCALE * 1.4426950408889634f;
    float mx0 = p0[0], mx1 = p1[0];
#pragma unroll
    for (int r = 1; r < 16; ++r) mx0 = fmaxf(mx0, p0[r]);
#pragma unroll
    for (int r = 1; r < 16; ++r) mx1 = fmaxf(mx1, p1[r]);
    float pmax = fmaxf(mx0 + off0, mx1 + off1);
    { auto rr = __builtin_amdgcn_permlane32_swap(__float_as_uint(pmax), __float_as_uint(pmax), false, false);
      pmax = fmaxf(__uint_as_float(rr[0]), __uint_as_float(rr[1])); }
    if (__all(pmax - m_reg < -SKIP_RAW)) { mn = m_reg; alpha = 1.f; return true; }
    if (__builtin_expect(__all(pmax - m_reg <= THR / SCALE), 1)) { mn = m_reg; alpha = 1.f; }
    else { mn = fmaxf(m_reg, pmax); alpha = __builtin_amdgcn_exp2f((m_reg - mn) * C); m_reg = mn; }
    const float a0 = (off0 - mn) * C, a1 = (off1 - mn) * C;
#pragma unroll
    for (int r = 0; r < 16; ++r) p0[r] = fmaf(p0[r], C, a0);
#pragma unroll
    for (int r = 0; r < 16; ++r) p1[r] = fmaf(p1[r], C, a1);
#pragma unroll
    for (int r = 0; r < 16; ++r) p0[r] = __builtin_amdgcn_exp2f(p0[r]);
    return false;
}
__device__ __forceinline__ void finishSM(f32x16& p0, f32x16& p1, float alpha, float& l_reg, bf16x8& pa0, bf16x8& pa1, bf16x8& pa2, bf16x8& pa3) {
#pragma unroll
    for (int r = 0; r < 16; ++r) p1[r] = __builtin_amdgcn_exp2f(p1[r]);
    float ps = 0;
#pragma unroll
    for (int r = 0; r < 16; ++r) ps += p0[r];
#pragma unroll
    for (int r = 0; r < 16; ++r) ps += p1[r];
    { auto rr = __builtin_amdgcn_permlane32_swap(__float_as_uint(ps), __float_as_uint(ps), false, false);
      ps = __uint_as_float(rr[0]) + __uint_as_float(rr[1]); }
    l_reg = l_reg * alpha + ps;
#define PK4(P, BASE, OUT) do { unsigned a0 = cvt_pk_bf16(P[BASE + 0], P[BASE + 1]), a1 = cvt_pk_bf16(P[BASE + 2], P[BASE + 3]);   \
    unsigned b0 = cvt_pk_bf16(P[BASE + 4], P[BASE + 5]), b1 = cvt_pk_bf16(P[BASE + 6], P[BASE + 7]);                              \
    auto r0 = __builtin_amdgcn_permlane32_swap(a0, b0, false, false); auto r1 = __builtin_amdgcn_permlane32_swap(a1, b1, false, false); \
    u32x4 w = {r0[0], r1[0], r0[1], r1[1]}; OUT = *reinterpret_cast<bf16x8*>(&w); } while (0)
    PK4(p0, 0, pa0); PK4(p0, 8, pa1); PK4(p1, 0, pa2); PK4(p1, 8, pa3);
#undef PK4
}
__device__ __forceinline__ void qkt(f32x16& p0, f32x16& p1, float& off0, float& off1, const char* Ks, const bf16x8* qr,
                                    int r32, int hi, int qp, int qw0, int k0, float nss) {
    bf16x8 kb[8];
#pragma unroll
    for (int d0 = 0; d0 < 4; ++d0) { const int cb = (d0 * 16 + hi * 8) * 2;
        kb[2 * d0] = *reinterpret_cast<const bf16x8*>(Ks + KSWZ(r32, cb)); kb[2 * d0 + 1] = *reinterpret_cast<const bf16x8*>(Ks + KSWZ(32 + r32, cb)); }
    if (k0 + KVBLK <= qw0 || k0 >= qw0 + QBLK) {
        const float sn = (k0 < qw0) ? -nss : nss, h4 = sn * (float)(4 * hi); f32x16 c0;
#pragma unroll
        for (int r = 0; r < 16; ++r) c0[r] = fmaf((float)((r & 3) + 8 * (r >> 2)), sn, h4);
        off0 = -sn * (float)(qp - k0); off1 = fmaf(32.f, sn, off0);
        asm volatile("s_waitcnt lgkmcnt(0)" ::: "memory"); SBAR();
        p0 = __builtin_amdgcn_mfma_f32_32x32x16_bf16(kb[0], qr[0], c0, 0, 0, 0);
        p1 = __builtin_amdgcn_mfma_f32_32x32x16_bf16(kb[1], qr[0], c0, 0, 0, 0);
    } else {
        const float dqh = (float)(qp - 4 * hi - k0); f32x16 c0, c1;
#pragma unroll
        for (int r = 0; r < 16; ++r) { const float c = (float)((r & 3) + 8 * (r >> 2)); c0[r] = nss * fabsf(dqh - c); c1[r] = nss * fabsf(dqh - (32.f + c)); }
        off0 = 0.f; off1 = 0.f;
        asm volatile("s_waitcnt lgkmcnt(0)" ::: "memory"); SBAR();
        p0 = __builtin_amdgcn_mfma_f32_32x32x16_bf16(kb[0], qr[0], c0, 0, 0, 0);
        p1 = __builtin_amdgcn_mfma_f32_32x32x16_bf16(kb[1], qr[0], c1, 0, 0, 0);
    }
#pragma unroll
    for (int d0 = 1; d0 < 4; ++d0) {
        p0 = __builtin_amdgcn_mfma_f32_32x32x16_bf16(kb[2 * d0], qr[d0], p0, 0, 0, 0);
        p1 = __builtin_amdgcn_mfma_f32_32x32x16_bf16(kb[2 * d0 + 1], qr[d0], p1, 0, 0, 0); }
}
__device__ __forceinline__ int v_st(int k, int c) { const int kk = (k & ~0xC) | ((k & 4) << 1) | ((k & 8) >> 1); return ((kk >> 3) * 4 + (c >> 5)) * 512 + ((kk & 7) * 32 + (c & 31)) * 2; }
__device__ __forceinline__ int v_rd_base(int lane) { return ((lane & 3) << 3) | (((lane >> 2) & 3) << 6) | (((lane >> 4) & 1) << 5) | (((lane >> 5) & 1) << 8); }
constexpr int v_rd_off(int d0, int ks, int half) { return d0 * 512 + ks * 4096 + half * 2048; }
template <int OFF> __device__ __forceinline__ s16x4 tr_read(int vb) {
    s16x4 r; asm volatile("ds_read_b64_tr_b16 %0, %1 offset:%2" : "=&v"(r) : "v"(vb), "i"(OFF) : "memory"); return r;
}
template <int KS> __device__ __forceinline__ void pv_ks(f32x16* o, int vb, bf16x8 pa) {
    const s16x4 l0 = tr_read<v_rd_off(0, KS, 0)>(vb), h0 = tr_read<v_rd_off(0, KS, 1)>(vb), l1 = tr_read<v_rd_off(1, KS, 0)>(vb), h1 = tr_read<v_rd_off(1, KS, 1)>(vb);
    const s16x4 l2 = tr_read<v_rd_off(2, KS, 0)>(vb), h2 = tr_read<v_rd_off(2, KS, 1)>(vb), l3 = tr_read<v_rd_off(3, KS, 0)>(vb), h3 = tr_read<v_rd_off(3, KS, 1)>(vb);
    asm volatile("s_waitcnt lgkmcnt(0)" ::: "memory"); SBAR();
#define PK(L, H) (bf16x8){L[0], L[1], L[2], L[3], H[0], H[1], H[2], H[3]}
    o[0] = __builtin_amdgcn_mfma_f32_32x32x16_bf16(pa, PK(l0, h0), o[0], 0, 0, 0);
    o[1] = __builtin_amdgcn_mfma_f32_32x32x16_bf16(pa, PK(l1, h1), o[1], 0, 0, 0);
    o[2] = __builtin_amdgcn_mfma_f32_32x32x16_bf16(pa, PK(l2, h2), o[2], 0, 0, 0);
    o[3] = __builtin_amdgcn_mfma_f32_32x32x16_bf16(pa, PK(l3, h3), o[3], 0, 0, 0);
#undef PK
}
__device__ __forceinline__ void pv_d0(f32x16* o, int vb, bf16x8 pa0, bf16x8 pa1, bf16x8 pa2, bf16x8 pa3) {
    pv_ks<0>(o, vb, pa0); pv_ks<1>(o, vb, pa1); pv_ks<2>(o, vb, pa2); pv_ks<3>(o, vb, pa3);
}

__device__ __forceinline__ void attn_body(const bf16_t* __restrict__ Qb, const bf16_t* __restrict__ Kh, const bf16_t* __restrict__ Vh,
                                          bf16_t* __restrict__ Ob, int qpos0, float nss, const float* __restrict__ ksq, char* lds) {
    const int tid = threadIdx.x, wid = __builtin_amdgcn_readfirstlane(tid >> 6), lane = tid & 63, r32 = lane & 31, hi = lane >> 5;
    char* V_lds = lds; char* K_lds = lds + 3 * SHM_V;
    float* ws = (float*)(lds + 3 * SHM_V + 2 * SHM_K) + wid * 64; float* li_l = ws; float* al_l = ws + 32;
    float m_reg = -1e30f, l_reg = 0; f32x16 o[4] = {}; bf16x8 qr[4];
    const bf16_t* Qw = Qb + (long)(wid * QBLK + r32) * LDZ + hi * 8;
#pragma unroll
    for (int d0 = 0; d0 < 4; ++d0) qr[d0] = *reinterpret_cast<const bf16x8*>(Qw + d0 * 16);
    LAS unsigned char* ldsl = (LAS unsigned char*)(uintptr_t)(unsigned)(uintptr_t)lds;
    int ksrc, vsrc0, vsrc1;
    { const int kb_ = wid * 1024 + lane * 16, krow = kb_ >> 7, kch = ((kb_ >> 4) & 7) ^ ((krow >> 1) & 7); ksrc = krow * LDZ + kch * 8;
      auto vsrc = [&](int b_) { const int sub = b_ >> 9, e = (b_ & 511) >> 1, kk = (sub >> 2) * 8 + (e >> 5), c = (sub & 3) * 32 + (e & 31);
                                const int k = (kk & ~0xC) | ((kk & 4) << 1) | ((kk & 8) >> 1); return k * LDZ + c; };
      vsrc0 = vsrc(wid * 1024 + lane * 16); vsrc1 = vsrc(8192 + wid * 1024 + lane * 16); }
    const int vb0 = (int)(uintptr_t)V_lds + v_rd_base(lane);
    constexpr int NT = SEQ / KVBLK;
    const int jstart = qpos0 / KVBLK;
    const int qw0 = qpos0 + wid * QBLK, qp = qw0 + r32;
    int vW = (int)SHM_V, vR = 2 * (int)SHM_V;
#define VNEXT(x) ((x) == 2 * (int)SHM_V ? 0 : (x) + (int)SHM_V)
#define TK(j) ((((j) + jstart) & (NT - 1)) * KVBLK)
#define SDMA(p, koff, voff) do { const long r0_ = (long)TK(p) * LDZ; \
    __builtin_amdgcn_global_load_lds((const unsigned*)(Kh + r0_ + ksrc), (LAS unsigned*)(ldsl + 3 * SHM_V + (koff) + wid * 1024), 16, 0, 0); \
    __builtin_amdgcn_global_load_lds((const unsigned*)(Vh + r0_ + vsrc0), (LAS unsigned*)(ldsl + (voff) + wid * 1024), 16, 0, 0); \
    __builtin_amdgcn_global_load_lds((const unsigned*)(Vh + r0_ + vsrc1), (LAS unsigned*)(ldsl + (voff) + 8192 + wid * 1024), 16, 0, 0); } while (0)
#define RESC(a) do { if (__any((a) < 1.f)) { if (hi == 0) al_l[r32] = (a); asm volatile("s_waitcnt lgkmcnt(0)" ::: "memory"); \
    _Pragma("unroll") for (int d = 0; d < 4; ++d) _Pragma("unroll") for (int r = 0; r < 16; ++r) o[d][r] *= al_l[crow(r, hi)]; } } while (0)
#define QKT(ks, p) qkt(p0, p1, off0, off1, K_lds + (ks) * (int)SHM_K, qr, r32, hi, qp, qw0, TK(p), nss)
#define SM() do { const bool sk_ = partialSM(p0, p1, off0, off1, m_reg, mn, alpha); RESC(alpha); if (!sk_) finishSM(p0, p1, alpha, l_reg, pa0, pa1, pa2, pa3); valid = !sk_; } while (0)
    f32x16 p0, p1; float mn, alpha, off0 = 0.f, off1 = 0.f; bf16x8 pa0, pa1, pa2, pa3; bool valid = false;
    const bool roleB = wid < 4;
    float* kmx = (float*)(lds + 3 * SHM_V + 2 * SHM_K + 2048); int* lst = (int*)(kmx + 64); float* red = (float*)(lst + 64);
    { const float* kp = ksq + (size_t)tid * 64; float mx = 0.f;
#pragma unroll
      for (int i = 0; i < 8; ++i) mx = fmaxf(mx, kp[i * 8]);
      mx = fmaxf(mx, __shfl_xor(mx, 1)); mx = fmaxf(mx, __shfl_xor(mx, 2)); mx = fmaxf(mx, __shfl_xor(mx, 4));
      if ((tid & 7) == 0) kmx[tid >> 3] = sqrtf(mx) * 1.01f;
      float qs = 0.f;
#pragma unroll
      for (int d0 = 0; d0 < 4; ++d0)
#pragma unroll
          for (int e = 0; e < 8; ++e) { const float v = __uint_as_float(((unsigned)(unsigned short)qr[d0][e]) << 16); qs = fmaf(v, v, qs); }
      { auto rr = __builtin_amdgcn_permlane32_swap(__float_as_uint(qs), __float_as_uint(qs), false, false); qs = __uint_as_float(rr[0]) + __uint_as_float(rr[1]); }
#pragma unroll
      for (int ofs = 16; ofs >= 1; ofs >>= 1) qs = fmaxf(qs, __shfl_xor(qs, ofs));
      if (lane == 0) red[8 + wid] = qs;
      if (tid < 64) lst[tid] = tid;
      if (tid == 0) ((int*)red)[16] = NT; }
    int n = NT;
    SDMA(0, 0, 0); asm volatile("s_waitcnt vmcnt(0)" ::: "memory"); __syncthreads();
#pragma unroll 1
    for (int j = 0; j < n; ++j) {
        if (j == 4) {
            if (wid == 0) {
                float ml = red[0], qm = red[8];
#pragma unroll
                for (int i = 1; i < 8; ++i) { ml = fminf(ml, red[i]); qm = fmaxf(qm, red[8 + i]); }
                const int t = (lane + jstart) & (NT - 1), k0 = t * KVBLK;
                const int dist = (k0 > qpos0 + 255) ? k0 - (qpos0 + 255) : ((qpos0 > k0 + 63) ? qpos0 - (k0 + 63) : 0);
                const float ub = sqrtf(qm) * 1.01f * kmx[t] + nss * (float)dist;
                const bool visit = (lane < 5) || !(ub - ml < -SKIP_RAW);
                const unsigned long long mask = __ballot(visit);
                const int rank = __popcll(mask & ((1ull << lane) - 1ull));
                if (visit) lst[rank] = lane;
                if (lane == 0) ((int*)red)[16] = __popcll(mask);
            }
            __syncthreads();
            n = __builtin_amdgcn_readfirstlane(((volatile int*)red)[16]);
        }
        const int pj = __builtin_amdgcn_readfirstlane(lst[j]), pn1 = __builtin_amdgcn_readfirstlane(lst[(j + 1 < n ? j + 1 : n - 1)]);
        if (j + 1 < n) SDMA(pn1, ((j + 1) & 1) * (int)SHM_K, vW);
        if (roleB && j > 0) SM();
        SBAR(); __builtin_amdgcn_s_setprio(1);
        QKT(j & 1, pj); if (valid) pv_d0(o, vb0 + vR, pa0, pa1, pa2, pa3);
        __builtin_amdgcn_s_setprio(0); SBAR();
        if (!roleB) SM();
        asm volatile("s_waitcnt vmcnt(0)" ::: "memory");
        if (j == 3) { float mw = m_reg;
#pragma unroll
            for (int ofs = 32; ofs >= 1; ofs >>= 1) mw = fminf(mw, __shfl_xor(mw, ofs));
            if (lane == 0) red[wid] = mw; }
        __syncthreads();
        vW = VNEXT(vW); vR = VNEXT(vR);
    }
    asm volatile("s_waitcnt vmcnt(0)" ::: "memory");
    if (roleB) SM();
    if (valid) pv_d0(o, vb0 + vR, pa0, pa1, pa2, pa3);
    if (hi == 0) li_l[r32] = l_reg; asm volatile("s_waitcnt lgkmcnt(0)" ::: "memory");
    float rli[16];
#pragma unroll
    for (int r = 0; r < 16; ++r) rli[r] = __builtin_amdgcn_rcpf(li_l[crow(r, hi)]);
    bf16_t* Ow = Ob + (long)(wid * QBLK) * LDO;
#pragma unroll
    for (int r = 0; r < 16; ++r) { const int orow = crow(r, hi);
#pragma unroll
        for (int d0 = 0; d0 < 4; d0 += 2) { const unsigned w = cvt_pk_bf16(o[d0][r] * rli[r], o[d0 + 1][r] * rli[r]);
            __hip_atomic_store(&Ow[(long)orow * LDO + d0 * 32 + r32], (bf16_t)(w & 0xffffu), __ATOMIC_RELAXED, __HIP_MEMORY_SCOPE_AGENT);
            __hip_atomic_store(&Ow[(long)orow * LDO + (d0 + 1) * 32 + r32], (bf16_t)(w >> 16), __ATOMIC_RELAXED, __HIP_MEMORY_SCOPE_AGENT); } }
#undef SDMA
#undef SWAIT
#undef RESC
#undef TK
#undef QKT
#undef VNEXT
#undef SM
}
}

template <bool CONVMAP>
__device__ __forceinline__ void wt_items(const float* __restrict__ W, const float* __restrict__ g, bf16_t* __restrict__ WT, int K, int N, long gtid, long gthreads) {
    const long items = (long)(K / 8) * N;
    for (long id = gtid; id < items; id += gthreads) {
        const int k8 = (int)(id & 3) + 4 * (int)(id / (4L * N)); const int n = (int)((id >> 2) % N);
        int src = n;
        if (CONVMAP && n >= 2048) { const int q = (n - 2048) >> 8, jj = (n - 2048) & 255, chn = 128 * (q & 3) + (jj & 127);
            src = (q < 4 ? (jj < 128 ? 2560 : 3072) : (jj < 128 ? 2048 : 3584)) + chn; }
        float v[8];
#pragma unroll
        for (int i = 0; i < 8; ++i) { const int k = k8 * 8 + i; v[i] = __builtin_nontemporal_load(W + (size_t)k * N + src) * (g ? g[k] : 1.f); }
        u32x4 w; w.x = cvt_pk_bf16(v[0], v[1]); w.y = cvt_pk_bf16(v[2], v[3]); w.z = cvt_pk_bf16(v[4], v[5]); w.w = cvt_pk_bf16(v[6], v[7]);
        *(u32x4*)(WT + (size_t)n * K + k8 * 8) = w;
    }
}
__device__ __forceinline__ void p0_prep(const Params& P) {
    const int tid = threadIdx.x, lane = tid & 63, wave = tid >> 6;
    const long gtid = (long)blockIdx.x * NTHREADS + tid, gthreads = (long)gridDim.x * NTHREADS;
    const int gw = blockIdx.x * 8 + wave, nw = gridDim.x * 8;
    bf16_t* xb = (bf16_t*)(P.ws + WS_XB);
    for (int row = gw; row < MTOK; row += 2 * nw) {
        const int row2 = row + nw;
        const float* xr = P.x + (size_t)row * DM; const float* xr2 = P.x + (size_t)(row2 < MTOK ? row2 : row) * DM; f32x4 v[4], w4[4]; float ss = 0.f, ss2 = 0.f;
#pragma unroll
        for (int i = 0; i < 4; ++i) { v[i] = __builtin_nontemporal_load((const f32x4*)(xr + i * 256 + lane * 4)); w4[i] = __builtin_nontemporal_load((const f32x4*)(xr2 + i * 256 + lane * 4)); }
#pragma unroll
        for (int i = 0; i < 4; ++i) { ss += v[i][0] * v[i][0] + v[i][1] * v[i][1] + v[i][2] * v[i][2] + v[i][3] * v[i][3]; ss2 += w4[i][0] * w4[i][0] + w4[i][1] * w4[i][1] + w4[i][2] * w4[i][2] + w4[i][3] * w4[i][3]; }
        ss = wave_sum(ss); ss2 = wave_sum(ss2);
        const float rs = __builtin_amdgcn_rsqf(ss * (1.f / DM) + EPS), rs2 = __builtin_amdgcn_rsqf(ss2 * (1.f / DM) + EPS);
#pragma unroll
        for (int i = 0; i < 4; ++i) { u32x2 w; w.x = cvt_pk_bf16(v[i][0] * rs, v[i][1] * rs); w.y = cvt_pk_bf16(v[i][2] * rs, v[i][3] * rs); *(u32x2*)(xb + (size_t)row * DM + i * 256 + lane * 4) = w; }
        if (row2 < MTOK) {
#pragma unroll
            for (int i = 0; i < 4; ++i) { u32x2 w; w.x = cvt_pk_bf16(w4[i][0] * rs2, w4[i][1] * rs2); w.y = cvt_pk_bf16(w4[i][2] * rs2, w4[i][3] * rs2); *(u32x2*)(xb + (size_t)row2 * DM + i * 256 + lane * 4) = w; } }
    }
    bf16_t* pb = (bf16_t*)(P.ws + WS_PB);
    for (long id = gtid; id < (long)MTOK * PLE / 8; id += gthreads) {
        const f32x4 a = *(const f32x4*)(P.p + id * 8), b = *(const f32x4*)(P.p + id * 8 + 4);
        u32x4 w; w.x = cvt_pk_bf16(a[0], a[1]); w.y = cvt_pk_bf16(a[2], a[3]); w.z = cvt_pk_bf16(b[0], b[1]); w.w = cvt_pk_bf16(b[2], b[3]);
        *(u32x4*)(pb + id * 8) = w;
    }
    { f32x4* kz = (f32x4*)(P.ws + WS_KSQ); for (long id = gtid; id < (long)MTOK * 2; id += gthreads) kz[id] = (f32x4){0.f, 0.f, 0.f, 0.f}; }
    wt_items<true>(P.w_in, P.g1, (bf16_t*)(P.ws + WS_WIN), DM, NIN, gtid, gthreads);
    wt_items<false>(P.w_p, nullptr, (bf16_t*)(P.ws + WS_WP), PLE, DM, gtid, gthreads);
}

template <int TOK> __device__ __forceinline__ void conv_chunk(const Params& P, int t0) {
    const int tid = threadIdx.x, lane = tid & 63, wave = tid >> 6;
    const bf16_t* z = (const bf16_t*)(P.ws + WS_Z); bf16_t* mix = (bf16_t*)(P.ws + WS_XB);
    const int c = lane * 8;
    float cw0[8], cw1[8], cw2[8];
#pragma unroll
    for (int i = 0; i < 8; ++i) { cw0[i] = P.conv_w[c + i]; cw1[i] = P.conv_w[512 + c + i]; cw2[i] = P.conv_w[1024 + c + i]; }
#pragma unroll 4
    for (int i8 = 0; i8 < TOK; ++i8) {
        const int t = t0 + wave * TOK + i8; const bf16_t* zr = z + (size_t)t * NIN;
        const int s = t & (SEQ - 1);
        const u32x4 zero4 = {0u, 0u, 0u, 0u};
        const u32x4 um4 = s > 0 ? *(const u32x4*)(zr - NIN + 2048 + c) : zero4, u04 = *(const u32x4*)(zr + 2048 + c), up4 = s < SEQ - 1 ? *(const u32x4*)(zr + NIN + 2048 + c) : zero4;
        const u32x4 v4 = *(const u32x4*)(zr + 2560 + c);
        float r[8];
#define CONV2(I, F) { r[I] = bf_lo(v4.F) * (cw0[I] * bf_lo(um4.F) + cw1[I] * bf_lo(u04.F) + cw2[I] * bf_lo(up4.F)); \
            r[I + 1] = bf_hi(v4.F) * (cw0[I + 1] * bf_hi(um4.F) + cw1[I + 1] * bf_hi(u04.F) + cw2[I + 1] * bf_hi(up4.F)); }
        CONV2(0, x) CONV2(2, y) CONV2(4, z) CONV2(6, w)
#undef CONV2
        u32x4 w; w.x = cvt_pk_bf16(r[0], r[1]); w.y = cvt_pk_bf16(r[2], r[3]); w.z = cvt_pk_bf16(r[4], r[5]); w.w = cvt_pk_bf16(r[6], r[7]);
        *(u32x4*)(mix + (size_t)t * DM + 512 + c) = w;
    }
}
__device__ __forceinline__ void p3_mix(const Params& P) {
    const int tid = threadIdx.x, lane = tid & 63, wave = tid >> 6;
    const int gw = blockIdx.x * 8 + wave, nw = gridDim.x * 8;
    const bf16_t* z = (const bf16_t*)(P.ws + WS_Z); const bf16_t* ao = (const bf16_t*)(P.ws + WS_AO); bf16_t* mix = (bf16_t*)(P.ws + WS_XB);
    const float s1 = wave_sum(P.lq1[lane] * P.lk1[lane]), s2 = wave_sum(P.lq2[lane] * P.lk2[lane]);
    const float lam = __expf(s1) - __expf(s2) + 0.2f;
    const int c = lane * 8;
    float sg[8];
#pragma unroll
    for (int i = 0; i < 8; ++i) sg[i] = P.subln_g[(c & 127) + i] * 0.8f;
    for (int t = gw; t < MTOK; t += nw) {
        const bf16_t* zr = z + (size_t)t * NIN;
        { const u32x4 a4 = *(const u32x4*)(ao + (size_t)t * 512 + c), b4 = *(const u32x4*)(ao + (size_t)(MTOK + t) * 512 + c);
          float u[8];
          u[0] = bf_lo(a4.x) - lam * bf_lo(b4.x); u[1] = bf_hi(a4.x) - lam * bf_hi(b4.x); u[2] = bf_lo(a4.y) - lam * bf_lo(b4.y); u[3] = bf_hi(a4.y) - lam * bf_hi(b4.y);
          u[4] = bf_lo(a4.z) - lam * bf_lo(b4.z); u[5] = bf_hi(a4.z) - lam * bf_hi(b4.z); u[6] = bf_lo(a4.w) - lam * bf_lo(b4.w); u[7] = bf_hi(a4.w) - lam * bf_hi(b4.w);
          float ss = 0.f;
#pragma unroll
          for (int i = 0; i < 8; ++i) ss += u[i] * u[i];
          ss += __shfl_xor(ss, 1); ss += __shfl_xor(ss, 2); ss += __shfl_xor(ss, 4); ss += __shfl_xor(ss, 8);
          const float rs = __builtin_amdgcn_rsqf(ss * (1.f / 128.f) + EPS);
          const u32x4 gw4 = *(const u32x4*)(zr + 1536 + c);
          float ga[8] = {bf_lo(gw4.x), bf_hi(gw4.x), bf_lo(gw4.y), bf_hi(gw4.y), bf_lo(gw4.z), bf_hi(gw4.z), bf_lo(gw4.w), bf_hi(gw4.w)};
          float r[8];
#pragma unroll
          for (int i = 0; i < 8; ++i) r[i] = u[i] * rs * sg[i] * silu_f(ga[i]);
          u32x4 w; w.x = cvt_pk_bf16(r[0], r[1]); w.y = cvt_pk_bf16(r[2], r[3]); w.z = cvt_pk_bf16(r[4], r[5]); w.w = cvt_pk_bf16(r[6], r[7]);
          *(u32x4*)(mix + (size_t)t * DM + c) = w; }
    }
}

__device__ __forceinline__ void subln_block(const Params& P, int tok0, int h) {
    const int tid = threadIdx.x, lane = tid & 63, wave = tid >> 6;
    const bf16_t* z = (const bf16_t*)(P.ws + WS_Z); const bf16_t* ao = (const bf16_t*)(P.ws + WS_AO); bf16_t* mix = (bf16_t*)(P.ws + WS_XB);
    const float s1 = wave_sum(P.lq1[lane] * P.lk1[lane]), s2 = wave_sum(P.lq2[lane] * P.lk2[lane]);
    const float lam = __expf(s1) - __expf(s2) + 0.2f;
    const int c = (lane & 15) * 8, col = h * 128 + c;
    float sg[8];
#pragma unroll
    for (int i = 0; i < 8; ++i) sg[i] = P.subln_g[c + i] * 0.8f;
#pragma unroll 4
    for (int it = 0; it < 8; ++it) {
        const int t = tok0 + wave * 32 + it * 4 + (lane >> 4);
        const u32x4 a4 = *(const u32x4*)(ao + (size_t)t * 512 + col), b4 = *(const u32x4*)(ao + (size_t)(MTOK + t) * 512 + col);
        const u32x4 gw4 = *(const u32x4*)(z + (size_t)t * NIN + 1536 + col);
        float u[8];
        u[0] = bf_lo(a4.x) - lam * bf_lo(b4.x); u[1] = bf_hi(a4.x) - lam * bf_hi(b4.x); u[2] = bf_lo(a4.y) - lam * bf_lo(b4.y); u[3] = bf_hi(a4.y) - lam * bf_hi(b4.y);
        u[4] = bf_lo(a4.z) - lam * bf_lo(b4.z); u[5] = bf_hi(a4.z) - lam * bf_hi(b4.z); u[6] = bf_lo(a4.w) - lam * bf_lo(b4.w); u[7] = bf_hi(a4.w) - lam * bf_hi(b4.w);
        float ss = 0.f;
#pragma unroll
        for (int i = 0; i < 8; ++i) ss += u[i] * u[i];
        ss += __shfl_xor(ss, 1); ss += __shfl_xor(ss, 2); ss += __shfl_xor(ss, 4); ss += __shfl_xor(ss, 8);
        const float rs = __builtin_amdgcn_rsqf(ss * (1.f / 128.f) + EPS);
        const float ga[8] = {bf_lo(gw4.x), bf_hi(gw4.x), bf_lo(gw4.y), bf_hi(gw4.y), bf_lo(gw4.z), bf_hi(gw4.z), bf_lo(gw4.w), bf_hi(gw4.w)};
        float r[8];
#pragma unroll
        for (int i = 0; i < 8; ++i) r[i] = u[i] * rs * sg[i] * silu_f(ga[i]);
        u32x4 w; w.x = cvt_pk_bf16(r[0], r[1]); w.y = cvt_pk_bf16(r[2], r[3]); w.z = cvt_pk_bf16(r[4], r[5]); w.w = cvt_pk_bf16(r[6], r[7]);
        *(u32x4*)(mix + (size_t)t * DM + col) = w;
    }
}

__global__ void __launch_bounds__(NTHREADS, 2) mega(Params P) {
    extern __shared__ __attribute__((aligned(16))) unsigned char lds[];
    cg::grid_group grid = cg::this_grid();
    const int lo = P.ph_lo, hi = P.ph_hi;
    const int G = gridDim.x;
#define IN(k) (lo <= (k) && (k) <= hi)
#define GBAR() do { if (P.use_cg) grid.sync(); else xcd_barrier(bar); } while (0)
#define SEAM(k) do { if (IN(k) && IN((k) + 1)) GBAR(); } while (0)
#define REPS(k) for (int rep_ = 0; rep_ < (((REP_MASK >> (k)) & 1) ? 2 : 1); ++rep_, (void)((((REP_MASK >> (k)) & 1) && rep_ == 1) ? ([&]{ GBAR(); }(), 0) : 0))
    unsigned char* ws = P.ws;
    volatile LAS unsigned* st = (volatile LAS unsigned*)((LAS unsigned char*)lds + LDS_STAGE);
    XcdBarrier bar; bar.bar = (unsigned*)(ws + WS_BAR); bar.x = 0; bar.st = st;
    if (lo != hi && !P.use_cg) {
        if (threadIdx.x == 0) { st[0] = 0u; st[1] = 0u; }
        __syncthreads();
        bar = xcd_barrier_post((unsigned*)(ws + WS_BAR), st);
    }
#ifdef EXTRA_SYNCS
    for (int i_ = 0; i_ < EXTRA_SYNCS; ++i_) GBAR();
#endif
    if (IN(0)) REPS(0) p0_prep(P);
    SEAM(0);
    if (IN(1)) REPS(1) {
        pg8::Gemm g{(const bf16_t*)(ws + WS_XB), (const bf16_t*)(ws + WS_WIN), MTOK, NIN, DM}; pg8::StaticOrder S; S.init(MTOK, NIN, G, (int)blockIdx.x);
        pg8::EpiZ E{(bf16_t*)(ws + WS_Z), nullptr, NIN, (float*)(ws + WS_KSQ)};
        pg8::gemm_phase<pg8::EpiZ>((LAS unsigned char*)lds, g, S, E);
    }
    SEAM(1);
    if (IN(2)) REPS(2) {
        const bf16_t* z = (const bf16_t*)(ws + WS_Z); bf16_t* ao = (bf16_t*)(ws + WS_AO);
        unsigned* pairc = (unsigned*)(ws + WS_BAR + 13824);
        unsigned* qhead = (unsigned*)(ws + WS_BAR + 15360);
        volatile LAS int* claim = (volatile LAS int*)((LAS unsigned char*)lds + LDS_STAGE + 16);
        int it = (int)blockIdx.x < 256 ? (int)blockIdx.x : 512;
        if (G < 256) it = 512;
        bool first = it < 256; int tailL = 1152;
        for (;;) {
            int b, h, j, qb;
            if (first) { const int xcd = it & 7, slot = it >> 3; b = xcd >> 1; h = 2 + (xcd & 1); j = slot >> 4; qb = slot & 15; first = false; }
            else {
                __syncthreads();
                if (threadIdx.x == 0) *claim = (int)__hip_atomic_fetch_add(qhead, 1u, __ATOMIC_RELAXED, __HIP_MEMORY_SCOPE_AGENT);
                __syncthreads();
                int L = *claim;
                if (G < 256) { if (L >= 512) { tailL = L - 256; break; } if (L < 256) { const int xcd = L & 7, slot = L >> 3; b = xcd >> 1; h = 2 + (xcd & 1); j = slot >> 4; qb = slot & 15; L = -1; } else L -= 256; }
                else if (L >= 256) { tailL = L; break; }
                if (L >= 0) { const int r = (L & 127) >> 3; h = L < 128 ? 1 : 0; b = (L & 7) >> 1; j = L & 1; qb = (r & 1) ? 8 + (r >> 1) : 7 - (r >> 1); }
            }
            const float slope = exp2f(-2.0f * (float)(h + 1));
            const size_t tok0 = (size_t)b * SEQ;
            __syncthreads();
            att::attn_body(z + (tok0 + qb * 256) * NIN + h * 128 + j * 64, z + tok0 * NIN + 512 + h * 128 + j * 64, z + tok0 * NIN + 1024 + h * 128,
                           ao + ((size_t)j * MTOK + tok0 + qb * 256) * 512 + h * 128, qb * 256, -slope / att::SCALE, (const float*)(ws + WS_KSQ) + tok0 * 8 + h * 2 + j, (char*)lds);
            asm volatile("s_waitcnt vmcnt(0)" ::: "memory"); __syncthreads();
            if (threadIdx.x == 0) {
                const unsigned old = __hip_atomic_fetch_add(pairc + ((b * 4 + h) * 16 + qb), 1u, __ATOMIC_RELAXED, __HIP_MEMORY_SCOPE_AGENT);
                if (old == 1u) { __builtin_amdgcn_fence(__ATOMIC_ACQUIRE, "agent"); asm volatile("s_waitcnt vmcnt(0)" ::: "memory"); }
                *claim = (int)old;
            }
            __syncthreads();
            if (*claim == 1) subln_block(P, (int)tok0 + qb * 256, h);
        }
        for (int L = tailL; L < 1152; ) {
            if (L < 512) { pg8::Gemm g{(const bf16_t*)(ws + WS_PB), (const bf16_t*)(ws + WS_WP), MTOK, DM, PLE}; pg8::StaticOrder S; S.init(MTOK, DM, 256, L - 256);
                           pg8::EpiZ E{(bf16_t*)(ws + WS_AO + 32 * MiB), nullptr, DM, nullptr};
                           __syncthreads(); pg8::gemm_phase<pg8::EpiZ>((LAS unsigned char*)lds, g, S, E); }
            else if (L >= 1024) { const long gt = (long)(L - 1024) * NTHREADS + threadIdx.x, gn = 128L * NTHREADS;
                   wt_items<false>(P.w_out, nullptr, (bf16_t*)(ws + WS_WOUT), DM, DM, gt, gn); wt_items<false>(P.w_g, P.g2, (bf16_t*)(ws + WS_WG), DM, DM, gt, gn); }
            else conv_chunk<4>(P, (L - 512) * 32);
            __syncthreads();
            if (threadIdx.x == 0) *claim = (int)__hip_atomic_fetch_add(qhead, 1u, __ATOMIC_RELAXED, __HIP_MEMORY_SCOPE_AGENT);
            __syncthreads();
            L = *claim - (G < 256 ? 256 : 0);
        }
    }
    SEAM(2);
    if (IN(4)) {
        for (int r4 = 0; r4 < (((REP_MASK >> 4) & 1) ? 2 : 1); ++r4)
        { pg8::Gemm g{(const bf16_t*)(ws + WS_XB), (const bf16_t*)(ws + WS_WOUT), MTOK, DM, DM}; pg8::StaticOrder S; S.init(MTOK, DM, G, (int)blockIdx.x);
          pg8::EpiRes E{P.x, P.out, (bf16_t*)(ws + WS_Z), (float*)(ws + WS_RSQ2)};
          pg8::gemm_phase<pg8::EpiRes>((LAS unsigned char*)lds, g, S, E); }
    }
    SEAM(4);
    if (IN(5)) {
        pg8::Gemm g{(const bf16_t*)(ws + WS_Z), (const bf16_t*)(ws + WS_WG), MTOK, DM, DM}; pg8::StaticOrder S; S.init(MTOK, DM, G, (int)blockIdx.x);
        pg8::EpiGateNorm E{(const bf16_t*)(ws + WS_Z), P.out, (const bf16_t*)(ws + WS_AO + 32 * MiB), (const float*)(ws + WS_RSQ2), (float*)(ws + WS_RSQ3), (unsigned*)(ws + WS_CNT), P.gf};
        pg8::gemm_phase<pg8::EpiGateNorm>((LAS unsigned char*)lds, g, S, E);
    }
#undef IN
#undef SEAM
}

extern "C" void kernel_launch(void* const* d_in, const int* in_sizes, int n_in, void* d_out, int out_size, void* d_ws, size_t ws_size, hipStream_t stream) {
    static int grid = 0;
    if (grid == 0) {
        if (n_in != 15 || in_sizes[0] != MTOK * DM || out_size != MTOK * DM || ws_size < WS_END) {
            fprintf(stderr, "kernel_launch: shape mismatch n_in %d in0 %d out %d ws %zu (need %zu)\n", n_in, n_in > 0 ? in_sizes[0] : -1, out_size, ws_size, (size_t)WS_END); grid = -1; return; }
        int dev = 0, cus = 0, per_cu = 0;
        (void)hipGetDevice(&dev); (void)hipDeviceGetAttribute(&cus, hipDeviceAttributeMultiprocessorCount, dev);
        if (hipFuncSetAttribute((const void*)mega, hipFuncAttributeMaxDynamicSharedMemorySize, LDS_BYTES) != hipSuccess) { fprintf(stderr, "kernel_launch: hipFuncSetAttribute failed\n"); grid = -1; return; }
        if (hipOccupancyMaxActiveBlocksPerMultiprocessor(&per_cu, (const void*)mega, NTHREADS, LDS_BYTES) != hipSuccess || per_cu < 1) { fprintf(stderr, "kernel_launch: occupancy query says %d\n", per_cu); per_cu = 1; }
        (void)hipGetLastError();
        grid = cus * 1;
        if (grid <= 0) grid = 256;
    }
    if (grid < 0) return;
    Params P{};
    P.x = (const float*)d_in[0]; P.p = (const float*)d_in[1]; P.g1 = (const float*)d_in[2]; P.w_in = (const float*)d_in[3];
    P.lq1 = (const float*)d_in[4]; P.lk1 = (const float*)d_in[5]; P.lq2 = (const float*)d_in[6]; P.lk2 = (const float*)d_in[7];
    P.subln_g = (const float*)d_in[8]; P.conv_w = (const float*)d_in[9]; P.w_out = (const float*)d_in[10]; P.g2 = (const float*)d_in[11];
    P.w_g = (const float*)d_in[12]; P.w_p = (const float*)d_in[13]; P.gf = (const float*)d_in[14];
    P.out = (float*)d_out; P.ws = (unsigned char*)d_ws;
    if (hipMemsetAsync((unsigned char*)d_ws + WS_BAR, 0, 32768, stream) != hipSuccess) { fprintf(stderr, "kernel_launch: memset of the barrier words failed\n"); return; }
#if MK_ONE_LAUNCH
    P.ph_lo = 0; P.ph_hi = 5; P.use_cg = 0;
    void* args[] = {&P};
    hipError_t e = hipLaunchCooperativeKernel((const void*)mega, dim3(grid), dim3(NTHREADS), args, LDS_BYTES, stream);
    if (e != hipSuccess) fprintf(stderr, "kernel_launch: cooperative launch failed: %s (grid %d)\n", hipGetErrorString(e), grid);
#else
    for (int ph = 0; ph <= 5; ++ph) {
        P.ph_lo = ph; P.ph_hi = ph;
        hipLaunchKernelGGL(mega, dim3(grid), dim3(NTHREADS), LDS_BYTES, stream, P);
        const hipError_t le = hipPeekAtLastError();
        if (le != hipSuccess) { fprintf(stderr, "kernel_launch: launch %d failed: %s\n", ph, hipGetErrorName(le)); break; }
    }
#endif
}
```

```cpp
#include <hip/hip_runtime.h>
#include <hip/hip_cooperative_groups.h>
#include <cstdio>
#include <cstdint>
namespace cg = cooperative_groups;

#ifndef MK_ONE_LAUNCH
#define MK_ONE_LAUNCH 1
#endif

#ifndef REP_MASK
#define REP_MASK 0
#endif
#define LAS __attribute__((address_space(3)))
typedef unsigned short bf16_t;
typedef short bf16x8 __attribute__((ext_vector_type(8)));
typedef short s16x4 __attribute__((ext_vector_type(4)));
typedef float f32x4 __attribute__((ext_vector_type(4)));
typedef float f32x8 __attribute__((ext_vector_type(8)));
typedef float f32x16 __attribute__((ext_vector_type(16)));
typedef unsigned u32x4 __attribute__((ext_vector_type(4)));
typedef unsigned u32x2 __attribute__((ext_vector_type(2)));

constexpr int DM = 1024, NB = 4, SEQ = 4096, MTOK = NB * SEQ, NIN = 4096, PLE = 256, NH = 4;
constexpr float EPS = 1e-6f;
constexpr int NTHREADS = 512;
constexpr int LDS_STAGE = 131072;
constexpr int LDS_BYTES = LDS_STAGE + 64;

constexpr size_t MiB = 1024 * 1024;
constexpr size_t WS_XB = 0;
constexpr size_t WS_WIN = WS_XB + 32 * MiB;
constexpr size_t WS_WOUT = WS_WIN + 8 * MiB;
constexpr size_t WS_WG = WS_WOUT + 2 * MiB;
constexpr size_t WS_WP = WS_WG + 2 * MiB;
constexpr size_t WS_PB = WS_WP + 1 * MiB;
constexpr size_t WS_Z = WS_PB + 8 * MiB;
constexpr size_t WS_AO = WS_Z + 128 * MiB;
constexpr size_t WS_RSTD1 = WS_AO + 64 * MiB;
constexpr size_t WS_RSQ2 = WS_RSTD1 + 65536;
constexpr size_t WS_RSQ3 = WS_RSQ2 + 1 * MiB;
constexpr size_t WS_BAR = WS_RSQ3 + 1 * MiB;
constexpr size_t WS_KSQ = WS_BAR + 32768;
constexpr size_t WS_CNT = WS_BAR + 16384;
constexpr size_t WS_END = WS_KSQ + (size_t)MTOK * 8 * 4;

struct Params {
    const float* x; const float* p; const float* g1; const float* w_in;
    const float* lq1; const float* lk1; const float* lq2; const float* lk2;
    const float* subln_g; const float* conv_w; const float* w_out; const float* g2;
    const float* w_g; const float* w_p; const float* gf;
    float* out; unsigned char* ws;
    int ph_lo, ph_hi, use_cg, pad;
};

__device__ __forceinline__ unsigned cvt_pk_bf16(float lo, float hi) { unsigned r; asm volatile("v_cvt_pk_bf16_f32 %0, %1, %2" : "=v"(r) : "v"(lo), "v"(hi)); return r; }
__device__ __forceinline__ float bf_lo(unsigned w) { return __uint_as_float(w << 16); }
__device__ __forceinline__ float bf_hi(unsigned w) { return __uint_as_float(w & 0xffff0000u); }
__device__ __forceinline__ float silu_f(float v) { return v * __builtin_amdgcn_rcpf(1.f + __expf(-v)); }
__device__ __forceinline__ float sigmoid_f(float v) { return __builtin_amdgcn_rcpf(1.f + __expf(-v)); }
__device__ __forceinline__ float wave_sum(float v) {
#pragma unroll
    for (int o = 32; o >= 1; o >>= 1) v += __shfl_xor(v, o);
    return v;
}


#define XB_TMO      128
#define XB_XCNT(j)  (256  + 64 * (j))
#define XB_XSUB(j)  (1280 + 64 * (j))
#define XB_XGEN(j)  (2304 + 64 * (j))
#define XB_TOP      3328
#define XB_TOPGEN   3392
#define XCD_BAR_WORDS 3456
#define XB_SPIN_CAP (1u << 20)
__device__ __forceinline__ unsigned xb_ld(unsigned* p)              { return __hip_atomic_load(p, __ATOMIC_RELAXED, __HIP_MEMORY_SCOPE_AGENT); }
__device__ __forceinline__ unsigned xb_add(unsigned* p, unsigned v) { return __hip_atomic_fetch_add(p, v, __ATOMIC_RELAXED, __HIP_MEMORY_SCOPE_AGENT); }
__device__ __forceinline__ unsigned xb_xcc_id() { return (unsigned)__builtin_amdgcn_s_getreg((3 << 11) | 20) & 0xFu; }
#define XB_SPIN(cond, bar) do { unsigned _sp = 0; while (cond) { __builtin_amdgcn_s_sleep(1); \
    if ((++_sp & 255u) == 0u) { if (xb_ld(&(bar)[XB_TMO])) break; if (_sp > XB_SPIN_CAP) { atomicAdd(&(bar)[XB_TMO], 1u); break; } } } } while (0)
struct XcdBarrier { unsigned* bar; unsigned x; volatile LAS unsigned* st; };
__device__ __forceinline__ XcdBarrier xcd_barrier_post(unsigned* bar, volatile LAS unsigned* st) {
    XcdBarrier b; b.bar = bar; b.x = xb_xcc_id(); b.st = st;
    if (threadIdx.x == 0) (void)xb_add(&bar[XB_XCNT(b.x)], 1u);
    return b;
}
__device__ __forceinline__ void xcd_barrier_complete(unsigned* bar, unsigned x, unsigned& nloc, unsigned& nx) {
    const unsigned G = gridDim.x * gridDim.y * gridDim.z;
    unsigned sum, cnt, mine, sp = 0u;
    for (;;) {
        sum = 0u; cnt = 0u; mine = 0u;
#pragma unroll
        for (unsigned j = 0; j < 16; ++j) { const unsigned c = xb_ld(&bar[XB_XCNT(j)]); sum += c; cnt += (c > 0u) ? 1u : 0u; mine = (j == x) ? c : mine; }
        if (sum == G) break;
        __builtin_amdgcn_s_sleep(1);
        if ((++sp & 255u) == 0u) { if (xb_ld(&bar[XB_TMO])) break; if (sp > XB_SPIN_CAP) { atomicAdd(&bar[XB_TMO], 1u); break; } }
    }
    nloc = mine > 0u ? mine : 1u; nx = cnt > 0u ? cnt : 1u;
}
__device__ __forceinline__ void xcd_barrier(const XcdBarrier& b) {
    asm volatile("s_waitcnt vmcnt(0)" ::: "memory");
    __syncthreads();
    if (threadIdx.x == 0) {
        unsigned* bar = b.bar;
        __builtin_amdgcn_s_waitcnt(0);
        unsigned nloc = b.st[0], nx = b.st[1];
        if (nloc == 0u) { xcd_barrier_complete(bar, b.x, nloc, nx); b.st[0] = nloc; b.st[1] = nx; }
        const unsigned old = xb_add(&bar[XB_XSUB(b.x)], 1u);
        const unsigned gen = old / nloc;
        if (old + 1u == (gen + 1u) * nloc) {
            __builtin_amdgcn_fence(__ATOMIC_RELEASE, "agent");
            asm volatile("s_waitcnt vmcnt(0)" ::: "memory");
            const unsigned og = xb_add(&bar[XB_TOP], 1u);
            const unsigned tg = og / nx;
            if (og + 1u == (tg + 1u) * nx) xb_add(&bar[XB_TOPGEN], 1u);
            else XB_SPIN(xb_ld(&bar[XB_TOPGEN]) == tg, bar);
            __builtin_amdgcn_fence(__ATOMIC_ACQUIRE, "agent");
            xb_add(&bar[XB_XGEN(b.x)], 1u);
            asm volatile("s_waitcnt vmcnt(0)" ::: "memory");
        } else {
            XB_SPIN(xb_ld(&bar[XB_XGEN(b.x)]) == gen, bar);
            __builtin_amdgcn_fence(__ATOMIC_ACQUIRE, "agent");
            asm volatile("s_waitcnt vmcnt(0)" ::: "memory");
        }
    }
    __syncthreads();
}

namespace pg8 {
constexpr int BM = 256, BK = 64, HALF = 128, HTB = HALF * BK * 2, STAGE_BYTES = 8 * HTB, NXCD = 8, WGM = 8;
__host__ __device__ __forceinline__ int lds_byte(int r, int c) { const int st = (r >> 4) * 2 + (c >> 5), rr = r & 15, cc = c & 31, ob = rr * 64 + cc * 2; return st * 1024 + (ob ^ (((ob >> 9) & 1) << 5)); }
__host__ __device__ __forceinline__ void stage_rc(int b, int& R, int& C) { const int st = b / 1024, sb = b % 1024, swz = sb ^ (((sb >> 9) & 1) << 5); R = (st >> 1) * 16 + swz / 64; C = (st & 1) * 32 + (swz % 64) / 2; }
__host__ __device__ __forceinline__ int perm32(int rho) { const int n = rho >> 4, i = rho & 15; return 8 * (i >> 2) + 4 * n + (i & 3); }
struct Unit { int pm, pn; };
struct Gemm { const bf16_t* A; const bf16_t* Bt; int M, N, K; };
struct StaticOrder {
    int nM, nN, nwg, G, c;
    __device__ void init(int M, int N, int G_, int c_) { nM = M / BM; nN = N / BM; nwg = nM * nN; G = G_; c = c_; }
    __device__ bool next(int i, Unit& u) const {
        const long L = (long)i * G + c; if (L >= nwg) return false;
        int wgid = (int)L; { const int q = nwg / NXCD, r = nwg % NXCD, xcd = wgid % NXCD, off = wgid / NXCD; wgid = (xcd < r ? xcd * (q + 1) : r * (q + 1) + (xcd - r) * q) + off; }
        const int nig = WGM * nN, gid = wgid / nig, fm = gid * WGM, gsz = (nM - fm) < WGM ? (nM - fm) : WGM;
        u.pm = fm + ((wgid % nig) % gsz); u.pn = (wgid % nig) / gsz; return true;
    }
};
template <class Epi>
__device__ __forceinline__ void gemm_phase(LAS unsigned char* lds, const Gemm g, const StaticOrder& S, const Epi& E) {
    const int tid = threadIdx.x, wid = __builtin_amdgcn_readfirstlane(tid >> 6), lane = tid & 63, wr = wid >> 2, wc = wid & 3, fr = lane & 15, fq = lane >> 4;
    const int K = g.K, nt = K / BK;
    unsigned voffA[2], voffB[2];
#pragma unroll
    for (int i = 0; i < 2; ++i) { int R, C; stage_rc(tid * 16 + i * 8192, R, C); const int Rb = Epi::PERM ? ((R & ~31) + perm32(R & 31)) : R;
        voffA[i] = (unsigned)(R * K + C) * 2u; voffB[i] = (unsigned)(Rb * K + C) * 2u; }
    const size_t kstep = (size_t)(BK * 2);
    const size_t hstep = (size_t)HALF * K * 2;
    const size_t tstep = 2 * hstep;
    const unsigned ldsw = (unsigned)wid * 1024u;
    const int aoff = lds_byte(wr * 64 + fr, fq * 8), boff = lds_byte(wc * 32 + fr, fq * 8);
#define PG8_SA(b, h) (((b) * 2 + (h)) * HTB)
#define PG8_SB(b, h) ((4 + (b) * 2 + (h)) * HTB)
#define PG8_STAGE(bufoff, gbase, voff) do { _Pragma("unroll") for (int _i = 0; _i < 2; ++_i) \
        __builtin_amdgcn_global_load_lds((const unsigned*)((const char*)(gbase) + (voff)[_i]), (LAS unsigned*)(lds + (bufoff) + ldsw + _i * 8192), 16, 0, 0); } while (0)
#define PG8_LDA(dst, b, h) do { _Pragma("unroll") for (int m = 0; m < 4; ++m) _Pragma("unroll") for (int k = 0; k < 2; ++k) dst[m][k] = *(const LAS bf16x8*)(lds + PG8_SA(b, h) + aoff + m * 2048 + k * 1024); } while (0)
#define PG8_LDB(dst, b, h) do { _Pragma("unroll") for (int n = 0; n < 2; ++n) _Pragma("unroll") for (int k = 0; k < 2; ++k) dst[n][k] = *(const LAS bf16x8*)(lds + PG8_SB(b, h) + boff + n * 2048 + k * 1024); } while (0)
#define PG8_MMA(ai, bj, At, Bt) do { __builtin_amdgcn_s_setprio(1); _Pragma("unroll") for (int m = 0; m < 4; ++m) _Pragma("unroll") for (int n = 0; n < 2; ++n) _Pragma("unroll") for (int k = 0; k < 2; ++k) \
        acc[ai][bj][m][n] = __builtin_amdgcn_mfma_f32_16x16x32_bf16(Bt[n][k], At[m][k], acc[ai][bj][m][n], 0, 0, 0); __builtin_amdgcn_s_setprio(0); } while (0)
#define PG8_WAIT_V(n) asm volatile("s_waitcnt vmcnt(" #n ")" ::: "memory")
#define PG8_WAIT_L(n) asm volatile("s_waitcnt lgkmcnt(" #n ")" ::: "memory")
#define PG8_BAR __builtin_amdgcn_s_barrier()
#define PG8_SCHED __builtin_amdgcn_sched_barrier(0)
    Unit cur, nxt; int ui = 0;
    if (!S.next(0, cur)) return;
    f32x4 acc[2][2][4][2];
#pragma unroll
    for (int a = 0; a < 2; ++a)
#pragma unroll
        for (int b = 0; b < 2; ++b)
#pragma unroll
            for (int m = 0; m < 4; ++m)
#pragma unroll
                for (int n = 0; n < 2; ++n) acc[a][b][m][n] = (f32x4){0.f, 0.f, 0.f, 0.f};
    bf16x8 At[4][2], B0[2][2], B1[2][2];
    const char* cA = (const char*)g.A + (size_t)cur.pm * tstep; const char* cB = (const char*)g.Bt + (size_t)cur.pn * tstep;
    PG8_STAGE(PG8_SB(0, 0), cB, voffB); PG8_STAGE(PG8_SA(0, 0), cA, voffA); PG8_STAGE(PG8_SB(0, 1), cB + hstep, voffB); PG8_STAGE(PG8_SA(0, 1), cA + hstep, voffA);
    if (wr == 1) PG8_BAR;
    PG8_WAIT_V(4); PG8_BAR;
    PG8_STAGE(PG8_SB(1, 0), cB + kstep, voffB); PG8_STAGE(PG8_SA(1, 0), cA + kstep, voffA); PG8_STAGE(PG8_SB(1, 1), cB + hstep + kstep, voffB);
    PG8_WAIT_V(6); PG8_BAR;
    for (;;) {
        const bool has_next = S.next(ui + 1, nxt);
        const char* nA = has_next ? (const char*)g.A + (size_t)nxt.pm * tstep : cA; const char* nB = has_next ? (const char*)g.Bt + (size_t)nxt.pn * tstep : cB;
        for (int t = 0; t < nt; t += 2) {
            const bool last = (t == nt - 2);
            const char* a1 = cA + (size_t)(t + 1) * kstep;
            const char* a2 = last ? nA : cA + (size_t)(t + 2) * kstep; const char* b2 = last ? nB : cB + (size_t)(t + 2) * kstep;
            const char* a3 = a2 + kstep; const char* b3 = b2 + kstep;
            PG8_LDB(B0, 0, 0); PG8_SCHED; PG8_LDA(At, 0, 0); PG8_STAGE(PG8_SA(1, 1), a1 + hstep, voffA);
            PG8_WAIT_L(8); PG8_BAR; PG8_WAIT_L(0); PG8_MMA(0, 0, At, B0); PG8_BAR; PG8_SCHED;
            PG8_LDB(B1, 0, 1); PG8_STAGE(PG8_SB(0, 0), b2, voffB);
            PG8_BAR; PG8_WAIT_L(0); PG8_MMA(0, 1, At, B1); PG8_BAR;
            PG8_LDA(At, 0, 1); PG8_STAGE(PG8_SA(0, 0), a2, voffA);
            PG8_BAR; PG8_WAIT_L(0); PG8_MMA(1, 0, At, B0); PG8_BAR; PG8_SCHED;
            PG8_STAGE(PG8_SB(0, 1), b2 + hstep, voffB);
            PG8_WAIT_V(6); PG8_BAR; PG8_MMA(1, 1, At, B1); PG8_BAR;
            PG8_LDB(B0, 1, 0); PG8_SCHED; PG8_LDA(At, 1, 0); PG8_STAGE(PG8_SA(0, 1), a2 + hstep, voffA);
            PG8_WAIT_L(8); PG8_BAR; PG8_WAIT_L(0); PG8_MMA(0, 0, At, B0); PG8_BAR; PG8_SCHED;
            PG8_LDB(B1, 1, 1); PG8_STAGE(PG8_SB(1, 0), b3, voffB);
            PG8_BAR; PG8_WAIT_L(0); PG8_MMA(0, 1, At, B1); PG8_BAR;
            PG8_LDA(At, 1, 1); PG8_STAGE(PG8_SA(1, 0), a3, voffA);
            PG8_BAR; PG8_WAIT_L(0); PG8_MMA(1, 0, At, B0); PG8_BAR; PG8_SCHED;
            PG8_STAGE(PG8_SB(1, 1), b3 + hstep, voffB);
            PG8_WAIT_V(6); PG8_BAR; PG8_MMA(1, 1, At, B1); PG8_BAR;
        }
        if constexpr (!Epi::AFTER_DRAIN) E(acc, cur, wr, wc, fr, fq);
        if (!has_next) break;
#pragma unroll
        for (int a = 0; a < 2; ++a)
#pragma unroll
            for (int b = 0; b < 2; ++b)
#pragma unroll
                for (int m = 0; m < 4; ++m)
#pragma unroll
                    for (int n = 0; n < 2; ++n) acc[a][b][m][n] = (f32x4){0.f, 0.f, 0.f, 0.f};
        cur = nxt; cA = nA; cB = nB; ++ui;
    }
    PG8_WAIT_V(0);
    if (wr == 0) PG8_BAR;
    PG8_BAR;
    if constexpr (Epi::AFTER_DRAIN) E.fused(acc, cur, wr, wc, fr, fq);
#undef PG8_SA
#undef PG8_SB
#undef PG8_STAGE
#undef PG8_LDA
#undef PG8_LDB
#undef PG8_MMA
#undef PG8_WAIT_V
#undef PG8_WAIT_L
#undef PG8_BAR
#undef PG8_SCHED
}

struct EpiZ {
    static constexpr bool PERM = true, AFTER_DRAIN = false;
    bf16_t* Z; const float* rstd; int ldz; float* ksq;
    __device__ __forceinline__ void operator()(const f32x4 (&acc)[2][2][4][2], const Unit& u, int wr, int wc, int fr, int fq) const {
        const int row0 = u.pm * BM + wr * 64 + fr, col0 = u.pn * BM + wc * 32 + 8 * fq;
        const bool kcols = ksq != nullptr && (u.pn >> 1) == 1;
        if (ksq != nullptr && u.pn >= 8) {
            const int q = u.pn - 8, chn0 = 128 * (q & 3) + 32 * wc + 8 * fq;
            bf16_t* base = Z + (q < 4 ? 2048 : 2560) + chn0;
#pragma unroll
            for (int ai = 0; ai < 2; ++ai)
#pragma unroll
                for (int m = 0; m < 4; ++m) { const int row = row0 + ai * HALF + m * 16;
                    const f32x4 a0 = acc[ai][0][m][0], a1 = acc[ai][0][m][1]; f32x4 b0 = acc[ai][1][m][0], b1 = acc[ai][1][m][1];
                    if (q >= 4) {
#pragma unroll
                        for (int i = 0; i < 4; ++i) { b0[i] = silu_f(b0[i]); b1[i] = silu_f(b1[i]); } }
                    u32x4 w; w.x = cvt_pk_bf16(a0[0] * b0[0], a0[1] * b0[1]); w.y = cvt_pk_bf16(a0[2] * b0[2], a0[3] * b0[3]);
                    w.z = cvt_pk_bf16(a1[0] * b1[0], a1[1] * b1[1]); w.w = cvt_pk_bf16(a1[2] * b1[2], a1[3] * b1[3]);
                    *(u32x4*)(base + (size_t)row * ldz) = w; }
            return;
        }
#pragma unroll
        for (int ai = 0; ai < 2; ++ai)
#pragma unroll
            for (int m = 0; m < 4; ++m) { const int row = row0 + ai * HALF + m * 16; const float rs = rstd ? rstd[row] : 1.f; bf16_t* rowp = Z + (size_t)row * ldz + col0;
#pragma unroll
                for (int bj = 0; bj < 2; ++bj) { const f32x4 v0 = acc[ai][bj][m][0] * rs, v1 = acc[ai][bj][m][1] * rs;
                    u32x4 w; w.x = cvt_pk_bf16(v0[0], v0[1]); w.y = cvt_pk_bf16(v0[2], v0[3]); w.z = cvt_pk_bf16(v1[0], v1[1]); w.w = cvt_pk_bf16(v1[2], v1[3]);
                    *(u32x4*)(rowp + bj * HALF) = w;
                    if (kcols) { float sq = v0[0] * v0[0] + v0[1] * v0[1] + v0[2] * v0[2] + v0[3] * v0[3] + v1[0] * v1[0] + v1[1] * v1[1] + v1[2] * v1[2] + v1[3] * v1[3];
                        sq += __shfl_xor(sq, 16); sq += __shfl_xor(sq, 32);
                        if (fq == 0) unsafeAtomicAdd(ksq + (size_t)row * 8 + (u.pn - 2) * 4 + bj * 2 + (wc >> 1), sq); } } }
    }
};
struct EpiRes {
    static constexpr bool PERM = true, AFTER_DRAIN = false;
    const float* X; float* O; bf16_t* Ob; float* rsq;
    __device__ __forceinline__ void operator()(const f32x4 (&acc)[2][2][4][2], const Unit& u, int wr, int wc, int fr, int fq) const {
        const int row0 = u.pm * BM + wr * 64 + fr, col0 = u.pn * BM + wc * 32 + 8 * fq;
#pragma unroll
        for (int ai = 0; ai < 2; ++ai)
#pragma unroll
            for (int m = 0; m < 4; ++m) { const int row = row0 + ai * HALF + m * 16; const size_t ro = (size_t)row * DM + col0; float ss = 0.f;
#pragma unroll
                for (int bj = 0; bj < 2; ++bj) { const f32x4 x0 = *(const f32x4*)(X + ro + bj * HALF), x1 = *(const f32x4*)(X + ro + bj * HALF + 4);
                    const f32x4 v0 = acc[ai][bj][m][0] + x0, v1 = acc[ai][bj][m][1] + x1;
                    u32x4 w; w.x = cvt_pk_bf16(v0[0], v0[1]); w.y = cvt_pk_bf16(v0[2], v0[3]); w.z = cvt_pk_bf16(v1[0], v1[1]); w.w = cvt_pk_bf16(v1[2], v1[3]);
                    *(u32x4*)(Ob + ro + bj * HALF) = w;
                    const float q0 = bf_lo(w.x), q1 = bf_hi(w.x), q2 = bf_lo(w.y), q3 = bf_hi(w.y), q4 = bf_lo(w.z), q5 = bf_hi(w.z), q6 = bf_lo(w.w), q7 = bf_hi(w.w);
                    ss += (q0 * q0 + q1 * q1 + q2 * q2 + q3 * q3) + (q4 * q4 + q5 * q5 + q6 * q6 + q7 * q7); }
                ss += __shfl_xor(ss, 16); ss += __shfl_xor(ss, 32);
                if (fq == 0) rsq[(size_t)row * 16 + u.pn * 4 + wc] = ss; }
    }
};
struct EpiGateNorm {
    static constexpr bool PERM = false, AFTER_DRAIN = true;
    const bf16_t* X1; float* O; const bf16_t* PP; const float* rsq_in; float* rsq; unsigned* cnt; const float* gf;
    __device__ __forceinline__ void fused(f32x4 (&acc)[2][2][4][2], const Unit& u, int wr, int wc, int fr, int fq) const {
        const int row0 = u.pm * BM + wr * 64 + fr, col0 = u.pn * BM + wc * 32 + 4 * fq;
#pragma unroll
        for (int ai = 0; ai < 2; ++ai)
#pragma unroll
            for (int m = 0; m < 4; ++m) { const int row = row0 + ai * HALF + m * 16; const size_t ro = (size_t)row * DM + col0; float ss = 0.f;
                const f32x4 rq = *(const f32x4*)(rsq_in + (size_t)row * 16 + fq * 4);
                float tot = (rq[0] + rq[1]) + (rq[2] + rq[3]);
                tot += __shfl_xor(tot, 16); tot += __shfl_xor(tot, 32);
                const float rs = __builtin_amdgcn_rsqf(tot * (1.f / DM) + EPS);
#pragma unroll
                for (int bj = 0; bj < 2; ++bj)
#pragma unroll
                    for (int n = 0; n < 2; ++n) { const u32x2 xw = *(const u32x2*)(X1 + ro + bj * HALF + n * 16); const f32x4 xv = {bf_lo(xw.x), bf_hi(xw.x), bf_lo(xw.y), bf_hi(xw.y)}; const u32x2 pw = *(const u32x2*)(PP + ro + bj * HALF + n * 16);
                        const f32x4 a = acc[ai][bj][m][n] * rs; f32x4 v;
                        v[0] = xv[0] + sigmoid_f(a[0]) * bf_lo(pw.x); v[1] = xv[1] + sigmoid_f(a[1]) * bf_hi(pw.x);
                        v[2] = xv[2] + sigmoid_f(a[2]) * bf_lo(pw.y); v[3] = xv[3] + sigmoid_f(a[3]) * bf_hi(pw.y);
                        acc[ai][bj][m][n] = v; ss += v[0] * v[0] + v[1] * v[1] + v[2] * v[2] + v[3] * v[3]; }
                ss += __shfl_xor(ss, 16); ss += __shfl_xor(ss, 32);
                if (fq == 0) __hip_atomic_store(rsq + (size_t)row * 16 + u.pn * 4 + wc, ss, __ATOMIC_RELAXED, __HIP_MEMORY_SCOPE_AGENT); }
        asm volatile("s_waitcnt vmcnt(0)" ::: "memory");
        __syncthreads();
        if (threadIdx.x == 0) {
            __builtin_amdgcn_fence(__ATOMIC_RELEASE, "agent");
            asm volatile("s_waitcnt vmcnt(0)" ::: "memory");
            (void)__hip_atomic_fetch_add(cnt + u.pm * 64, 1u, __ATOMIC_RELAXED, __HIP_MEMORY_SCOPE_AGENT);
            unsigned sp = 0u;
            while (__hip_atomic_load(cnt + u.pm * 64, __ATOMIC_RELAXED, __HIP_MEMORY_SCOPE_AGENT) < 4u) { __builtin_amdgcn_s_sleep(1); if (++sp > (1u << 22)) break; }
            __builtin_amdgcn_fence(__ATOMIC_ACQUIRE, "agent");
            asm volatile("s_waitcnt vmcnt(0)" ::: "memory");
        }
        __syncthreads();
        f32x4 gv[2][2];
#pragma unroll
        for (int bj = 0; bj < 2; ++bj)
#pragma unroll
            for (int n = 0; n < 2; ++n) gv[bj][n] = *(const f32x4*)(gf + col0 + bj * HALF + n * 16);
#pragma unroll
        for (int ai = 0; ai < 2; ++ai)
#pragma unroll
            for (int m = 0; m < 4; ++m) { const int row = row0 + ai * HALF + m * 16; const size_t ro = (size_t)row * DM + col0;
                const f32x4 pq = *(const f32x4*)(rsq + (size_t)row * 16 + fq * 4);
                float tot = (pq[0] + pq[1]) + (pq[2] + pq[3]);
                tot += __shfl_xor(tot, 16); tot += __shfl_xor(tot, 32);
                const float rs = __builtin_amdgcn_rsqf(tot * (1.f / DM) + EPS);
#pragma unroll
                for (int bj = 0; bj < 2; ++bj)
#pragma unroll
                    for (int n = 0; n < 2; ++n) *(f32x4*)(O + ro + bj * HALF + n * 16) = acc[ai][bj][m][n] * rs * gv[bj][n]; }
    }
};
}

namespace att {
constexpr int NW = 8, QBLK = 32, KVBLK = 64, DV = 128, DQ = 64;
constexpr int LDZ = NIN, LDO = 512;
constexpr float SCALE = 0.125f;
constexpr float THR = 12.f;
constexpr size_t SHM_V = KVBLK * DV * 2, SHM_K = KVBLK * DQ * 2;
#define KSWZ(row, colB) ((row) * 128 + ((colB) ^ ((((row) >> 1) & 7) << 4)))
#define SBAR() __builtin_amdgcn_sched_barrier(0)
__device__ __forceinline__ int crow(int r, int hi) { return (r & 3) + 8 * (r >> 2) + 4 * hi; }
constexpr float SKIP_RAW = 40.f / (SCALE * 1.4426950408889634f);
__device__ __forceinline__ bool partialSM(f32x16& p0, f32x16& p1, float off0, float off1, float& m_reg, float& mn, float& alpha) {
    constexpr float C = SCALE * 1.4426950408889634f;
    float mx0 = p0[0], mx1 = p1[0];
#pragma unroll
    for (int r = 1; r < 16; ++r) mx0 = fmaxf(mx0, p0[r]);
#pragma unroll
    for (int r = 1; r < 16; ++r) mx1 = fmaxf(mx1, p1[r]);
    float pmax = fmaxf(mx0 + off0, mx1 + off1);
    { auto rr = __builtin_amdgcn_permlane32_swap(__float_as_uint(pmax), __float_as_uint(pmax), false, false);
      pmax = fmaxf(__uint_as_float(rr[0]), __uint_as_float(rr[1])); }
    if (__all(pmax - m_reg < -SKIP_RAW)) { mn = m_reg; alpha = 1.f; return true; }
    if (__builtin_expect(__all(pmax - m_reg <= THR / SCALE), 1)) { mn = m_reg; alpha = 1.f; }
    else { mn = fmaxf(m_reg, pmax); alpha = __builtin_amdgcn_exp2f((m_reg - mn) * C); m_reg = mn; }
    const float a0 = (off0 - mn) * C, a1 = (off1 - mn) * C;
#pragma unroll
    for (int r = 0; r < 16; ++r) p0[r] = fmaf(p0[r], C, a0);
#pragma unroll
    for (int r = 0; r < 16; ++r) p1[r] = fmaf(p1[r], C, a1);
#pragma unroll
    for (int r = 0; r < 16; ++r) p0[r] = __builtin_amdgcn_exp2f(p0[r]);
    return false;
}
__device__ __forceinline__ void finishSM(f32x16& p0, f32x16& p1, float alpha, float& l_reg, bf16x8& pa0, bf16x8& pa1, bf16x8& pa2, bf16x8& pa3) {
#pragma unroll
    for (int r = 0; r < 16; ++r) p1[r] = __builtin_amdgcn_exp2f(p1[r]);
    float ps = 0;
#pragma unroll
    for (int r = 0; r < 16; ++r) ps += p0[r];
#pragma unroll
    for (int r = 0; r < 16; ++r) ps += p1[r];
    { auto rr = __builtin_amdgcn_permlane32_swap(__float_as_uint(ps), __float_as_uint(ps), false, false);
      ps = __uint_as_float(rr[0]) + __uint_as_float(rr[1]); }
    l_reg = l_reg * alpha + ps;
#define PK4(P, BASE, OUT) do { unsigned a0 = cvt_pk_bf16(P[BASE + 0], P[BASE + 1]), a1 = cvt_pk_bf16(P[BASE + 2], P[BASE + 3]);   \
    unsigned b0 = cvt_pk_bf16(P[BASE + 4], P[BASE + 5]), b1 = cvt_pk_bf16(P[BASE + 6], P[BASE + 7]);                              \
    auto r0 = __builtin_amdgcn_permlane32_swap(a0, b0, false, false); auto r1 = __builtin_amdgcn_permlane32_swap(a1, b1, false, false); \
    u32x4 w = {r0[0], r1[0], r0[1], r1[1]}; OUT = *reinterpret_cast<bf16x8*>(&w); } while (0)
    PK4(p0, 0, pa0); PK4(p0, 8, pa1); PK4(p1, 0, pa2); PK4(p1, 8, pa3);
#undef PK4
}
__device__ __forceinline__ void qkt(f32x16& p0, f32x16& p1, float& off0, float& off1, const char* Ks, const bf16x8* qr,
                                    int r32, int hi, int qp, int qw0, int k0, float nss) {
    bf16x8 kb[8];
#pragma unroll
    for (int d0 = 0; d0 < 4; ++d0) { const int cb = (d0 * 16 + hi * 8) * 2;
        kb[2 * d0] = *reinterpret_cast<const bf16x8*>(Ks + KSWZ(r32, cb)); kb[2 * d0 + 1] = *reinterpret_cast<const bf16x8*>(Ks + KSWZ(32 + r32, cb)); }
    if (k0 + KVBLK <= qw0 || k0 >= qw0 + QBLK) {
        const float sn = (k0 < qw0) ? -nss : nss, h4 = sn * (float)(4 * hi); f32x16 c0;
#pragma unroll
        for (int r = 0; r < 16; ++r) c0[r] = fmaf((float)((r & 3) + 8 * (r >> 2)), sn, h4);
        off0 = -sn * (float)(qp - k0); off1 = fmaf(32.f, sn, off0);
        asm volatile("s_waitcnt lgkmcnt(0)" ::: "memory"); SBAR();
        p0 = __builtin_amdgcn_mfma_f32_32x32x16_bf16(kb[0], qr[0], c0, 0, 0, 0);
        p1 = __builtin_amdgcn_mfma_f32_32x32x16_bf16(kb[1], qr[0], c0, 0, 0, 0);
    } else {
        const float dqh = (float)(qp - 4 * hi - k0); f32x16 c0, c1;
#pragma unroll
        for (int r = 0; r < 16; ++r) { const float c = (float)((r & 3) + 8 * (r >> 2)); c0[r] = nss * fabsf(dqh - c); c1[r] = nss * fabsf(dqh - (32.f + c)); }
        off0 = 0.f; off1 = 0.f;
        asm volatile("s_waitcnt lgkmcnt(0)" ::: "memory"); SBAR();
        p0 = __builtin_amdgcn_mfma_f32_32x32x16_bf16(kb[0], qr[0], c0, 0, 0, 0);
        p1 = __builtin_amdgcn_mfma_f32_32x32x16_bf16(kb[1], qr[0], c1, 0, 0, 0);
    }
#pragma unroll
    for (int d0 = 1; d0 < 4; ++d0) {
        p0 = __builtin_amdgcn_mfma_f32_32x32x16_bf16(kb[2 * d0], qr[d0], p0, 0, 0, 0);
        p1 = __builtin_amdgcn_mfma_f32_32x32x16_bf16(kb[2 * d0 + 1], qr[d0], p1, 0, 0, 0); }
}
__device__ __forceinline__ int v_st(int k, int c) { const int kk = (k & ~0xC) | ((k & 4) << 1) | ((k & 8) >> 1); return ((kk >> 3) * 4 + (c >> 5)) * 512 + ((kk & 7) * 32 + (c & 31)) * 2; }
__device__ __forceinline__ int v_rd_base(int lane) { return ((lane & 3) << 3) | (((lane >> 2) & 3) << 6) | (((lane >> 4) & 1) << 5) | (((lane >> 5) & 1) << 8); }
constexpr int v_rd_off(int d0, int ks, int half) { return d0 * 512 + ks * 4096 + half * 2048; }
template <int OFF> __device__ __forceinline__ s16x4 tr_read(int vb) {
    s16x4 r; asm volatile("ds_read_b64_tr_b16 %0, %1 offset:%2" : "=&v"(r) : "v"(vb), "i"(OFF) : "memory"); return r;
}
template <int KS> __device__ __forceinline__ void pv_ks(f32x16* o, int vb, bf16x8 pa) {
    const s16x4 l0 = tr_read<v_rd_off(0, KS, 0)>(vb), h0 = tr_read<v_rd_off(0, KS, 1)>(vb), l1 = tr_read<v_rd_off(1, KS, 0)>(vb), h1 = tr_read<v_rd_off(1, KS, 1)>(vb);
    const s16x4 l2 = tr_read<v_rd_off(2, KS, 0)>(vb), h2 = tr_read<v_rd_off(2, KS, 1)>(vb), l3 = tr_read<v_rd_off(3, KS, 0)>(vb), h3 = tr_read<v_rd_off(3, KS, 1)>(vb);
    asm volatile("s_waitcnt lgkmcnt(0)" ::: "memory"); SBAR();
#define PK(L, H) (bf16x8){L[0], L[1], L[2], L[3], H[0], H[1], H[2], H[3]}
    o[0] = __builtin_amdgcn_mfma_f32_32x32x16_bf16(pa, PK(l0, h0), o[0], 0, 0, 0);
    o[1] = __builtin_amdgcn_mfma_f32_32x32x16_bf16(pa, PK(l1, h1), o[1], 0, 0, 0);
    o[2] = __builtin_amdgcn_mfma_f32_32x32x16_bf16(pa, PK(l2, h2), o[2], 0, 0, 0);
    o[3] = __builtin_amdgcn_mfma_f32_32x32x16_bf16(pa, PK(l3, h3), o[3], 0, 0, 0);
#undef PK
}
__device__ __forceinline__ void pv_d0(f32x16* o, int vb, bf16x8 pa0, bf16x8 pa1, bf16x8 pa2, bf16x8 pa3) {
    pv_ks<0>(o, vb, pa0); pv_ks<1>(o, vb, pa1); pv_ks<2>(o, vb, pa2); pv_ks<3>(o, vb, pa3);
}

__device__ __forceinline__ void attn_body(const bf16_t* __restrict__ Qb, const bf16_t* __restrict__ Kh, const bf16_t* __restrict__ Vh,
                                          bf16_t* __restrict__ Ob, int qpos0, float nss, const float* __restrict__ ksq, char* lds) {
    const int tid = threadIdx.x, wid = __builtin_amdgcn_readfirstlane(tid >> 6), lane = tid & 63, r32 = lane & 31, hi = lane >> 5;
    char* V_lds = lds; char* K_lds = lds + 3 * SHM_V;
    float* ws = (float*)(lds + 3 * SHM_V + 2 * SHM_K) + wid * 64; float* li_l = ws; float* al_l = ws + 32;
    float m_reg = -1e30f, l_reg = 0; f32x16 o[4] = {}; bf16x8 qr[4];
    const bf16_t* Qw = Qb + (long)(wid * QBLK + r32) * LDZ + hi * 8;
#pragma unroll
    for (int d0 = 0; d0 < 4; ++d0) qr[d0] = *reinterpret_cast<const bf16x8*>(Qw + d0 * 16);
    LAS unsigned char* ldsl = (LAS unsigned char*)(uintptr_t)(unsigned)(uintptr_t)lds;
    int ksrc, vsrc0, vsrc1;
    { const int kb_ = wid * 1024 + lane * 16, krow = kb_ >> 7, kch = ((kb_ >> 4) & 7) ^ ((krow >> 1) & 7); ksrc = krow * LDZ + kch * 8;
      auto vsrc = [&](int b_) { const int sub = b_ >> 9, e = (b_ & 511) >> 1, kk = (sub >> 2) * 8 + (e >> 5), c = (sub & 3) * 32 + (e & 31);
                                const int k = (kk & ~0xC) | ((kk & 4) << 1) | ((kk & 8) >> 1); return k * LDZ + c; };
      vsrc0 = vsrc(wid * 1024 + lane * 16); vsrc1 = vsrc(8192 + wid * 1024 + lane * 16); }
    const int vb0 = (int)(uintptr_t)V_lds + v_rd_base(lane);
    constexpr int NT = SEQ / KVBLK;
    const int jstart = qpos0 / KVBLK;
    const int qw0 = qpos0 + wid * QBLK, qp = qw0 + r32;
    int vW = (int)SHM_V, vR = 2 * (int)SHM_V;
#define VNEXT(x) ((x) == 2 * (int)SHM_V ? 0 : (x) + (int)SHM_V)
#define TK(j) ((((j) + jstart) & (NT - 1)) * KVBLK)
#define SDMA(p, koff, voff) do { const long r0_ = (long)TK(p) * LDZ; \
    __builtin_amdgcn_global_load_lds((const unsigned*)(Kh + r0_ + ksrc), (LAS unsigned*)(ldsl + 3 * SHM_V + (koff) + wid * 1024), 16, 0, 0); \
    __builtin_amdgcn_global_load_lds((const unsigned*)(Vh + r0_ + vsrc0), (LAS unsigned*)(ldsl + (voff) + wid * 1024), 16, 0, 0); \
    __builtin_amdgcn_global_load_lds((const unsigned*)(Vh + r0_ + vsrc1), (LAS unsigned*)(ldsl + (voff) + 8192 + wid * 1024), 16, 0, 0); } while (0)
#define RESC(a) do { if (__any((a) < 1.f)) { if (hi == 0) al_l[r32] = (a); asm volatile("s_waitcnt lgkmcnt(0)" ::: "memory"); \
    _Pragma("unroll") for (int d = 0; d < 4; ++d) _Pragma("unroll") for (int r = 0; r < 16; ++r) o[d][r] *= al_l[crow(r, hi)]; } } while (0)
#define QKT(ks, p) qkt(p0, p1, off0, off1, K_lds + (ks) * (int)SHM_K, qr, r32, hi, qp, qw0, TK(p), nss)
#define SM() do { const bool sk_ = partialSM(p0, p1, off0, off1, m_reg, mn, alpha); RESC(alpha); if (!sk_) finishSM(p0, p1, alpha, l_reg, pa0, pa1, pa2, pa3); valid = !sk_; } while (0)
    f32x16 p0, p1; float mn, alpha, off0 = 0.f, off1 = 0.f; bf16x8 pa0, pa1, pa2, pa3; bool valid = false;
    const bool roleB = wid < 4;
    float* kmx = (float*)(lds + 3 * SHM_V + 2 * SHM_K + 2048); int* lst = (int*)(kmx + 64); float* red = (float*)(lst + 64);
    { const float* kp = ksq + (size_t)tid * 64; float mx = 0.f;
#pragma unroll
      for (int i = 0; i < 8; ++i) mx = fmaxf(mx, kp[i * 8]);
      mx = fmaxf(mx, __shfl_xor(mx, 1)); mx = fmaxf(mx, __shfl_xor(mx, 2)); mx = fmaxf(mx, __shfl_xor(mx, 4));
      if ((tid & 7) == 0) kmx[tid >> 3] = sqrtf(mx) * 1.01f;
      float qs = 0.f;
#pragma unroll
      for (int d0 = 0; d0 < 4; ++d0)
#pragma unroll
          for (int e = 0; e < 8; ++e) { const float v = __uint_as_float(((unsigned)(unsigned short)qr[d0][e]) << 16); qs = fmaf(v, v, qs); }
      { auto rr = __builtin_amdgcn_permlane32_swap(__float_as_uint(qs), __float_as_uint(qs), false, false); qs = __uint_as_float(rr[0]) + __uint_as_float(rr[1]); }
#pragma unroll
      for (int ofs = 16; ofs >= 1; ofs >>= 1) qs = fmaxf(qs, __shfl_xor(qs, ofs));
      if (lane == 0) red[8 + wid] = qs;
      if (tid < 64) lst[tid] = tid;
      if (tid == 0) ((int*)red)[16] = NT; }
    int n = NT;
    SDMA(0, 0, 0); asm volatile("s_waitcnt vmcnt(0)" ::: "memory"); __syncthreads();
#pragma unroll 1
    for (int j = 0; j < n; ++j) {
        if (j == 4) {
            if (wid == 0) {
                float ml = red[0], qm = red[8];
#pragma unroll
                for (int i = 1; i < 8; ++i) { ml = fminf(ml, red[i]); qm = fmaxf(qm, red[8 + i]); }
                const int t = (lane + jstart) & (NT - 1), k0 = t * KVBLK;
                const int dist = (k0 > qpos0 + 255) ? k0 - (qpos0 + 255) : ((qpos0 > k0 + 63) ? qpos0 - (k0 + 63) : 0);
                const float ub = sqrtf(qm) * 1.01f * kmx[t] + nss * (float)dist;
                const bool visit = (lane < 5) || !(ub - ml < -SKIP_RAW);
                const unsigned long long mask = __ballot(visit);
                const int rank = __popcll(mask & ((1ull << lane) - 1ull));
                if (visit) lst[rank] = lane;
                if (lane == 0) ((int*)red)[16] = __popcll(mask);
            }
            __syncthreads();
            n = __builtin_amdgcn_readfirstlane(((volatile int*)red)[16]);
        }
        const int pj = __builtin_amdgcn_readfirstlane(lst[j]), pn1 = __builtin_amdgcn_readfirstlane(lst[(j + 1 < n ? j + 1 : n - 1)]);
        if (j + 1 < n) SDMA(pn1, ((j + 1) & 1) * (int)SHM_K, vW);
        if (roleB && j > 0) SM();
        SBAR(); __builtin_amdgcn_s_setprio(1);
        QKT(j & 1, pj); if (valid) pv_d0(o, vb0 + vR, pa0, pa1, pa2, pa3);
        __builtin_amdgcn_s_setprio(0); SBAR();
        if (!roleB) SM();
        asm volatile("s_waitcnt vmcnt(0)" ::: "memory");
        if (j == 3) { float mw = m_reg;
#pragma unroll
            for (int ofs = 32; ofs >= 1; ofs >>= 1) mw = fminf(mw, __shfl_xor(mw, ofs));
            if (lane == 0) red[wid] = mw; }
        __syncthreads();
        vW = VNEXT(vW); vR = VNEXT(vR);
    }
    asm volatile("s_waitcnt vmcnt(0)" ::: "memory");
    if (roleB) SM();
    if (valid) pv_d0(o, vb0 + vR, pa0, pa1, pa2, pa3);
    if (hi == 0) li_l[r32] = l_reg; asm volatile("s_waitcnt lgkmcnt(0)" ::: "memory");
    float rli[16];
#pragma unroll
    for (int r = 0; r < 16; ++r) rli[r] = __builtin_amdgcn_rcpf(li_l[crow(r, hi)]);
    bf16_t* Ow = Ob + (long)(wid * QBLK) * LDO;
#pragma unroll
    for (int r = 0; r < 16; ++r) { const int orow = crow(r, hi);
#pragma unroll
        for (int d0 = 0; d0 < 4; d0 += 2) { const unsigned w = cvt_pk_bf16(o[d0][r] * rli[r], o[d0 + 1][r] * rli[r]);
            __hip_atomic_store(&Ow[(long)orow * LDO + d0 * 32 + r32], (bf16_t)(w & 0xffffu), __ATOMIC_RELAXED, __HIP_MEMORY_SCOPE_AGENT);
            __hip_atomic_store(&Ow[(long)orow * LDO + (d0 + 1) * 32 + r32], (bf16_t)(w >> 16), __ATOMIC_RELAXED, __HIP_MEMORY_SCOPE_AGENT); } }
#undef SDMA
#undef SWAIT
#undef RESC
#undef TK
#undef QKT
#undef VNEXT
#undef SM
}
}

template <bool CONVMAP>
__device__ __forceinline__ void wt_items(const float* __restrict__ W, const float* __restrict__ g, bf16_t* __restrict__ WT, int K, int N, long gtid, long gthreads) {
    const long items = (long)(K / 8) * N;
    for (long id = gtid; id < items; id += gthreads) {
        const int k8 = (int)(id & 3) + 4 * (int)(id / (4L * N)); const int n = (int)((id >> 2) % N);
        int src = n;
        if (CONVMAP && n >= 2048) { const int q = (n - 2048) >> 8, jj = (n - 2048) & 255, chn = 128 * (q & 3) + (jj & 127);
            src = (q < 4 ? (jj < 128 ? 2560 : 3072) : (jj < 128 ? 2048 : 3584)) + chn; }
        float v[8];
#pragma unroll
        for (int i = 0; i < 8; ++i) { const int k = k8 * 8 + i; v[i] = __builtin_nontemporal_load(W + (size_t)k * N + src) * (g ? g[k] : 1.f); }
        u32x4 w; w.x = cvt_pk_bf16(v[0], v[1]); w.y = cvt_pk_bf16(v[2], v[3]); w.z = cvt_pk_bf16(v[4], v[5]); w.w = cvt_pk_bf16(v[6], v[7]);
        *(u32x4*)(WT + (size_t)n * K + k8 * 8) = w;
    }
}
__device__ __forceinline__ void p0_prep(const Params& P) {
    const int tid = threadIdx.x, lane = tid & 63, wave = tid >> 6;
    const long gtid = (long)blockIdx.x * NTHREADS + tid, gthreads = (long)gridDim.x * NTHREADS;
    const int gw = blockIdx.x * 8 + wave, nw = gridDim.x * 8;
    bf16_t* xb = (bf16_t*)(P.ws + WS_XB);
    for (int row = gw; row < MTOK; row += 2 * nw) {
        const int row2 = row + nw;
        const float* xr = P.x + (size_t)row * DM; const float* xr2 = P.x + (size_t)(row2 < MTOK ? row2 : row) * DM; f32x4 v[4], w4[4]; float ss = 0.f, ss2 = 0.f;
#pragma unroll
        for (int i = 0; i < 4; ++i) { v[i] = __builtin_nontemporal_load((const f32x4*)(xr + i * 256 + lane * 4)); w4[i] = __builtin_nontemporal_load((const f32x4*)(xr2 + i * 256 + lane * 4)); }
#pragma unroll
        for (int i = 0; i < 4; ++i) { ss += v[i][0] * v[i][0] + v[i][1] * v[i][1] + v[i][2] * v[i][2] + v[i][3] * v[i][3]; ss2 += w4[i][0] * w4[i][0] + w4[i][1] * w4[i][1] + w4[i][2] * w4[i][2] + w4[i][3] * w4[i][3]; }
        ss = wave_sum(ss); ss2 = wave_sum(ss2);
        const float rs = __builtin_amdgcn_rsqf(ss * (1.f / DM) + EPS), rs2 = __builtin_amdgcn_rsqf(ss2 * (1.f / DM) + EPS);
#pragma unroll
        for (int i = 0; i < 4; ++i) { u32x2 w; w.x = cvt_pk_bf16(v[i][0] * rs, v[i][1] * rs); w.y = cvt_pk_bf16(v[i][2] * rs, v[i][3] * rs); *(u32x2*)(xb + (size_t)row * DM + i * 256 + lane * 4) = w; }
        if (row2 < MTOK) {
#pragma unroll
            for (int i = 0; i < 4; ++i) { u32x2 w; w.x = cvt_pk_bf16(w4[i][0] * rs2, w4[i][1] * rs2); w.y = cvt_pk_bf16(w4[i][2] * rs2, w4[i][3] * rs2); *(u32x2*)(xb + (size_t)row2 * DM + i * 256 + lane * 4) = w; } }
    }
    bf16_t* pb = (bf16_t*)(P.ws + WS_PB);
    for (long id = gtid; id < (long)MTOK * PLE / 8; id += gthreads) {
        const f32x4 a = *(const f32x4*)(P.p + id * 8), b = *(const f32x4*)(P.p + id * 8 + 4);
        u32x4 w; w.x = cvt_pk_bf16(a[0], a[1]); w.y = cvt_pk_bf16(a[2], a[3]); w.z = cvt_pk_bf16(b[0], b[1]); w.w = cvt_pk_bf16(b[2], b[3]);
        *(u32x4*)(pb + id * 8) = w;
    }
    { f32x4* kz = (f32x4*)(P.ws + WS_KSQ); for (long id = gtid; id < (long)MTOK * 2; id += gthreads) kz[id] = (f32x4){0.f, 0.f, 0.f, 0.f}; }
    wt_items<true>(P.w_in, P.g1, (bf16_t*)(P.ws + WS_WIN), DM, NIN, gtid, gthreads);
    wt_items<false>(P.w_out, nullptr, (bf16_t*)(P.ws + WS_WOUT), DM, DM, gtid, gthreads);
    wt_items<false>(P.w_g, P.g2, (bf16_t*)(P.ws + WS_WG), DM, DM, gtid, gthreads);
    wt_items<false>(P.w_p, nullptr, (bf16_t*)(P.ws + WS_WP), PLE, DM, gtid, gthreads);
}

template <int TOK> __device__ __forceinline__ void conv_chunk(const Params& P, int t0) {
    const int tid = threadIdx.x, lane = tid & 63, wave = tid >> 6;
    const bf16_t* z = (const bf16_t*)(P.ws + WS_Z); bf16_t* mix = (bf16_t*)(P.ws + WS_XB);
    const int c = lane * 8;
    float cw0[8], cw1[8], cw2[8];
#pragma unroll
    for (int i = 0; i < 8; ++i) { cw0[i] = P.conv_w[c + i]; cw1[i] = P.conv_w[512 + c + i]; cw2[i] = P.conv_w[1024 + c + i]; }
#pragma unroll 4
    for (int i8 = 0; i8 < TOK; ++i8) {
        const int t = t0 + wave * TOK + i8; const bf16_t* zr = z + (size_t)t * NIN;
        const int s = t & (SEQ - 1);
        const u32x4 zero4 = {0u, 0u, 0u, 0u};
        const u32x4 um4 = s > 0 ? *(const u32x4*)(zr - NIN + 2048 + c) : zero4, u04 = *(const u32x4*)(zr + 2048 + c), up4 = s < SEQ - 1 ? *(const u32x4*)(zr + NIN + 2048 + c) : zero4;
        const u32x4 v4 = *(const u32x4*)(zr + 2560 + c);
        float r[8];
#define CONV2(I, F) { r[I] = bf_lo(v4.F) * (cw0[I] * bf_lo(um4.F) + cw1[I] * bf_lo(u04.F) + cw2[I] * bf_lo(up4.F)); \
            r[I + 1] = bf_hi(v4.F) * (cw0[I + 1] * bf_hi(um4.F) + cw1[I + 1] * bf_hi(u04.F) + cw2[I + 1] * bf_hi(up4.F)); }
        CONV2(0, x) CONV2(2, y) CONV2(4, z) CONV2(6, w)
#undef CONV2
        u32x4 w; w.x = cvt_pk_bf16(r[0], r[1]); w.y = cvt_pk_bf16(r[2], r[3]); w.z = cvt_pk_bf16(r[4], r[5]); w.w = cvt_pk_bf16(r[6], r[7]);
        *(u32x4*)(mix + (size_t)t * DM + 512 + c) = w;
    }
}
__device__ __forceinline__ void p3_mix(const Params& P) {
    const int tid = threadIdx.x, lane = tid & 63, wave = tid >> 6;
    const int gw = blockIdx.x * 8 + wave, nw = gridDim.x * 8;
    const bf16_t* z = (const bf16_t*)(P.ws + WS_Z); const bf16_t* ao = (const bf16_t*)(P.ws + WS_AO); bf16_t* mix = (bf16_t*)(P.ws + WS_XB);
    const float s1 = wave_sum(P.lq1[lane] * P.lk1[lane]), s2 = wave_sum(P.lq2[lane] * P.lk2[lane]);
    const float lam = __expf(s1) - __expf(s2) + 0.2f;
    const int c = lane * 8;
    float sg[8];
#pragma unroll
    for (int i = 0; i < 8; ++i) sg[i] = P.subln_g[(c & 127) + i] * 0.8f;
    for (int t = gw; t < MTOK; t += nw) {
        const bf16_t* zr = z + (size_t)t * NIN;
        { const u32x4 a4 = *(const u32x4*)(ao + (size_t)t * 512 + c), b4 = *(const u32x4*)(ao + (size_t)(MTOK + t) * 512 + c);
          float u[8];
          u[0] = bf_lo(a4.x) - lam * bf_lo(b4.x); u[1] = bf_hi(a4.x) - lam * bf_hi(b4.x); u[2] = bf_lo(a4.y) - lam * bf_lo(b4.y); u[3] = bf_hi(a4.y) - lam * bf_hi(b4.y);
          u[4] = bf_lo(a4.z) - lam * bf_lo(b4.z); u[5] = bf_hi(a4.z) - lam * bf_hi(b4.z); u[6] = bf_lo(a4.w) - lam * bf_lo(b4.w); u[7] = bf_hi(a4.w) - lam * bf_hi(b4.w);
          float ss = 0.f;
#pragma unroll
          for (int i = 0; i < 8; ++i) ss += u[i] * u[i];
          ss += __shfl_xor(ss, 1); ss += __shfl_xor(ss, 2); ss += __shfl_xor(ss, 4); ss += __shfl_xor(ss, 8);
          const float rs = __builtin_amdgcn_rsqf(ss * (1.f / 128.f) + EPS);
          const u32x4 gw4 = *(const u32x4*)(zr + 1536 + c);
          float ga[8] = {bf_lo(gw4.x), bf_hi(gw4.x), bf_lo(gw4.y), bf_hi(gw4.y), bf_lo(gw4.z), bf_hi(gw4.z), bf_lo(gw4.w), bf_hi(gw4.w)};
          float r[8];
#pragma unroll
          for (int i = 0; i < 8; ++i) r[i] = u[i] * rs * sg[i] * silu_f(ga[i]);
          u32x4 w; w.x = cvt_pk_bf16(r[0], r[1]); w.y = cvt_pk_bf16(r[2], r[3]); w.z = cvt_pk_bf16(r[4], r[5]); w.w = cvt_pk_bf16(r[6], r[7]);
          *(u32x4*)(mix + (size_t)t * DM + c) = w; }
    }
}

__device__ __forceinline__ void subln_block(const Params& P, int tok0, int h) {
    const int tid = threadIdx.x, lane = tid & 63, wave = tid >> 6;
    const bf16_t* z = (const bf16_t*)(P.ws + WS_Z); const bf16_t* ao = (const bf16_t*)(P.ws + WS_AO); bf16_t* mix = (bf16_t*)(P.ws + WS_XB);
    const float s1 = wave_sum(P.lq1[lane] * P.lk1[lane]), s2 = wave_sum(P.lq2[lane] * P.lk2[lane]);
    const float lam = __expf(s1) - __expf(s2) + 0.2f;
    const int c = (lane & 15) * 8, col = h * 128 + c;
    float sg[8];
#pragma unroll
    for (int i = 0; i < 8; ++i) sg[i] = P.subln_g[c + i] * 0.8f;
#pragma unroll 4
    for (int it = 0; it < 8; ++it) {
        const int t = tok0 + wave * 32 + it * 4 + (lane >> 4);
        const u32x4 a4 = *(const u32x4*)(ao + (size_t)t * 512 + col), b4 = *(const u32x4*)(ao + (size_t)(MTOK + t) * 512 + col);
        const u32x4 gw4 = *(const u32x4*)(z + (size_t)t * NIN + 1536 + col);
        float u[8];
        u[0] = bf_lo(a4.x) - lam * bf_lo(b4.x); u[1] = bf_hi(a4.x) - lam * bf_hi(b4.x); u[2] = bf_lo(a4.y) - lam * bf_lo(b4.y); u[3] = bf_hi(a4.y) - lam * bf_hi(b4.y);
        u[4] = bf_lo(a4.z) - lam * bf_lo(b4.z); u[5] = bf_hi(a4.z) - lam * bf_hi(b4.z); u[6] = bf_lo(a4.w) - lam * bf_lo(b4.w); u[7] = bf_hi(a4.w) - lam * bf_hi(b4.w);
        float ss = 0.f;
#pragma unroll
        for (int i = 0; i < 8; ++i) ss += u[i] * u[i];
        ss += __shfl_xor(ss, 1); ss += __shfl_xor(ss, 2); ss += __shfl_xor(ss, 4); ss += __shfl_xor(ss, 8);
        const float rs = __builtin_amdgcn_rsqf(ss * (1.f / 128.f) + EPS);
        const float ga[8] = {bf_lo(gw4.x), bf_hi(gw4.x), bf_lo(gw4.y), bf_hi(gw4.y), bf_lo(gw4.z), bf_hi(gw4.z), bf_lo(gw4.w), bf_hi(gw4.w)};
        float r[8];
#pragma unroll
        for (int i = 0; i < 8; ++i) r[i] = u[i] * rs * sg[i] * silu_f(ga[i]);
        u32x4 w; w.x = cvt_pk_bf16(r[0], r[1]); w.y = cvt_pk_bf16(r[2], r[3]); w.z = cvt_pk_bf16(r[4], r[5]); w.w = cvt_pk_bf16(r[6], r[7]);
        *(u32x4*)(mix + (size_t)t * DM + col) = w;
    }
}

__global__ void __launch_bounds__(NTHREADS, 2) mega(Params P) {
    extern __shared__ __attribute__((aligned(16))) unsigned char lds[];
    cg::grid_group grid = cg::this_grid();
    const int lo = P.ph_lo, hi = P.ph_hi;
    const int G = gridDim.x;
#define IN(k) (lo <= (k) && (k) <= hi)
#define GBAR() do { if (P.use_cg) grid.sync(); else xcd_barrier(bar); } while (0)
#define SEAM(k) do { if (IN(k) && IN((k) + 1)) GBAR(); } while (0)
#define REPS(k) for (int rep_ = 0; rep_ < (((REP_MASK >> (k)) & 1) ? 2 : 1); ++rep_, (void)((((REP_MASK >> (k)) & 1) && rep_ == 1) ? ([&]{ GBAR(); }(), 0) : 0))
    unsigned char* ws = P.ws;
    volatile LAS unsigned* st = (volatile LAS unsigned*)((LAS unsigned char*)lds + LDS_STAGE);
    XcdBarrier bar; bar.bar = (unsigned*)(ws + WS_BAR); bar.x = 0; bar.st = st;
    if (lo != hi && !P.use_cg) {
        if (threadIdx.x == 0) { st[0] = 0u; st[1] = 0u; }
        __syncthreads();
        bar = xcd_barrier_post((unsigned*)(ws + WS_BAR), st);
    }
#ifdef EXTRA_SYNCS
    for (int i_ = 0; i_ < EXTRA_SYNCS; ++i_) GBAR();
#endif
    if (IN(0)) REPS(0) p0_prep(P);
    SEAM(0);
    if (IN(1)) REPS(1) {
        pg8::Gemm g{(const bf16_t*)(ws + WS_XB), (const bf16_t*)(ws + WS_WIN), MTOK, NIN, DM}; pg8::StaticOrder S; S.init(MTOK, NIN, G, (int)blockIdx.x);
        pg8::EpiZ E{(bf16_t*)(ws + WS_Z), nullptr, NIN, (float*)(ws + WS_KSQ)};
        pg8::gemm_phase<pg8::EpiZ>((LAS unsigned char*)lds, g, S, E);
    }
    SEAM(1);
    if (IN(2)) REPS(2) {
        const bf16_t* z = (const bf16_t*)(ws + WS_Z); bf16_t* ao = (bf16_t*)(ws + WS_AO);
        unsigned* pairc = (unsigned*)(ws + WS_BAR + 13824);
        unsigned* qhead = (unsigned*)(ws + WS_BAR + 15360);
        volatile LAS int* claim = (volatile LAS int*)((LAS unsigned char*)lds + LDS_STAGE + 16);
        int it = (int)blockIdx.x < 256 ? (int)blockIdx.x : 512;
        if (G < 256) it = 512;
        bool first = it < 256; int tailL = 1024;
        for (;;) {
            int b, h, j, qb;
            if (first) { const int xcd = it & 7, slot = it >> 3; b = xcd >> 1; h = 2 + (xcd & 1); j = slot >> 4; qb = slot & 15; first = false; }
            else {
                __syncthreads();
                if (threadIdx.x == 0) *claim = (int)__hip_atomic_fetch_add(qhead, 1u, __ATOMIC_RELAXED, __HIP_MEMORY_SCOPE_AGENT);
                __syncthreads();
                int L = *claim;
                if (G < 256) { if (L >= 512) { tailL = L - 256; break; } if (L < 256) { const int xcd = L & 7, slot = L >> 3; b = xcd >> 1; h = 2 + (xcd & 1); j = slot >> 4; qb = slot & 15; L = -1; } else L -= 256; }
                else if (L >= 256) { tailL = L; break; }
                if (L >= 0) { const int r = (L & 127) >> 3; h = L < 128 ? 1 : 0; b = (L & 7) >> 1; j = L & 1; qb = (r & 1) ? 8 + (r >> 1) : 7 - (r >> 1); }
            }
            const float slope = exp2f(-2.0f * (float)(h + 1));
            const size_t tok0 = (size_t)b * SEQ;
            __syncthreads();
            att::attn_body(z + (tok0 + qb * 256) * NIN + h * 128 + j * 64, z + tok0 * NIN + 512 + h * 128 + j * 64, z + tok0 * NIN + 1024 + h * 128,
                           ao + ((size_t)j * MTOK + tok0 + qb * 256) * 512 + h * 128, qb * 256, -slope / att::SCALE, (const float*)(ws + WS_KSQ) + tok0 * 8 + h * 2 + j, (char*)lds);
            asm volatile("s_waitcnt vmcnt(0)" ::: "memory"); __syncthreads();
            if (threadIdx.x == 0) {
                const unsigned old = __hip_atomic_fetch_add(pairc + ((b * 4 + h) * 16 + qb), 1u, __ATOMIC_RELAXED, __HIP_MEMORY_SCOPE_AGENT);
                if (old == 1u) { __builtin_amdgcn_fence(__ATOMIC_ACQUIRE, "agent"); asm volatile("s_waitcnt vmcnt(0)" ::: "memory"); }
                *claim = (int)old;
            }
            __syncthreads();
            if (*claim == 1) subln_block(P, (int)tok0 + qb * 256, h);
        }
        for (int L = tailL; L < 1024; ) {
            if (L < 512) { pg8::Gemm g{(const bf16_t*)(ws + WS_PB), (const bf16_t*)(ws + WS_WP), MTOK, DM, PLE}; pg8::StaticOrder S; S.init(MTOK, DM, 256, L - 256);
                           pg8::EpiZ E{(bf16_t*)(ws + WS_AO + 32 * MiB), nullptr, DM, nullptr};
                           __syncthreads(); pg8::gemm_phase<pg8::EpiZ>((LAS unsigned char*)lds, g, S, E); }
            else conv_chunk<4>(P, (L - 512) * 32);
            __syncthreads();
            if (threadIdx.x == 0) *claim = (int)__hip_atomic_fetch_add(qhead, 1u, __ATOMIC_RELAXED, __HIP_MEMORY_SCOPE_AGENT);
            __syncthreads();
            L = *claim - (G < 256 ? 256 : 0);
        }
    }
    SEAM(2);
    if (IN(4)) {
        for (int r4 = 0; r4 < (((REP_MASK >> 4) & 1) ? 2 : 1); ++r4)
        { pg8::Gemm g{(const bf16_t*)(ws + WS_XB), (const bf16_t*)(ws + WS_WOUT), MTOK, DM, DM}; pg8::StaticOrder S; S.init(MTOK, DM, G, (int)blockIdx.x);
          pg8::EpiRes E{P.x, P.out, (bf16_t*)(ws + WS_Z), (float*)(ws + WS_RSQ2)};
          pg8::gemm_phase<pg8::EpiRes>((LAS unsigned char*)lds, g, S, E); }
    }
    SEAM(4);
    if (IN(5)) {
        pg8::Gemm g{(const bf16_t*)(ws + WS_Z), (const bf16_t*)(ws + WS_WG), MTOK, DM, DM}; pg8::StaticOrder S; S.init(MTOK, DM, G, (int)blockIdx.x);
        pg8::EpiGateNorm E{(const bf16_t*)(ws + WS_Z), P.out, (const bf16_t*)(ws + WS_AO + 32 * MiB), (const float*)(ws + WS_RSQ2), (float*)(ws + WS_RSQ3), (unsigned*)(ws + WS_CNT), P.gf};
        pg8::gemm_phase<pg8::EpiGateNorm>((LAS unsigned char*)lds, g, S, E);
    }
#undef IN
#undef SEAM
}

extern "C" void kernel_launch(void* const* d_in, const int* in_sizes, int n_in, void* d_out, int out_size, void* d_ws, size_t ws_size, hipStream_t stream) {
    static int grid = 0;
    if (grid == 0) {
        if (n_in != 15 || in_sizes[0] != MTOK * DM || out_size != MTOK * DM || ws_size < WS_END) {
            fprintf(stderr, "kernel_launch: shape mismatch n_in %d in0 %d out %d ws %zu (need %zu)\n", n_in, n_in > 0 ? in_sizes[0] : -1, out_size, ws_size, (size_t)WS_END); grid = -1; return; }
        int dev = 0, cus = 0, per_cu = 0;
        (void)hipGetDevice(&dev); (void)hipDeviceGetAttribute(&cus, hipDeviceAttributeMultiprocessorCount, dev);
        if (hipFuncSetAttribute((const void*)mega, hipFuncAttributeMaxDynamicSharedMemorySize, LDS_BYTES) != hipSuccess) { fprintf(stderr, "kernel_launch: hipFuncSetAttribute failed\n"); grid = -1; return; }
        if (hipOccupancyMaxActiveBlocksPerMultiprocessor(&per_cu, (const void*)mega, NTHREADS, LDS_BYTES) != hipSuccess || per_cu < 1) { fprintf(stderr, "kernel_launch: occupancy query says %d\n", per_cu); per_cu = 1; }
        (void)hipGetLastError();
        grid = cus * 1;
        if (grid <= 0) grid = 256;
    }
    if (grid < 0) return;
    Params P{};
    P.x = (const float*)d_in[0]; P.p = (const float*)d_in[1]; P.g1 = (const float*)d_in[2]; P.w_in = (const float*)d_in[3];
    P.lq1 = (const float*)d_in[4]; P.lk1 = (const float*)d_in[5]; P.lq2 = (const float*)d_in[6]; P.lk2 = (const float*)d_in[7];
    P.subln_g = (const float*)d_in[8]; P.conv_w = (const float*)d_in[9]; P.w_out = (const float*)d_in[10]; P.g2 = (const float*)d_in[11];
    P.w_g = (const float*)d_in[12]; P.w_p = (const float*)d_in[13]; P.gf = (const float*)d_in[14];
    P.out = (float*)d_out; P.ws = (unsigned char*)d_ws;
    if (hipMemsetAsync((unsigned char*)d_ws + WS_BAR, 0, 32768, stream) != hipSuccess) { fprintf(stderr, "kernel_launch: memset of the barrier words failed\n"); return; }
#if MK_ONE_LAUNCH
    P.ph_lo = 0; P.ph_hi = 5; P.use_cg = 0;
    void* args[] = {&P};
    hipError_t e = hipLaunchCooperativeKernel((const void*)mega, dim3(grid), dim3(NTHREADS), args, LDS_BYTES, stream);
    if (e != hipSuccess) fprintf(stderr, "kernel_launch: cooperative launch failed: %s (grid %d)\n", hipGetErrorString(e), grid);
#else
    for (int ph = 0; ph <= 5; ++ph) {
        P.ph_lo = ph; P.ph_hi = ph;
        hipLaunchKernelGGL(mega, dim3(grid), dim3(NTHREADS), LDS_BYTES, stream, P);
        const hipError_t le = hipPeekAtLastError();
        if (le != hipSuccess) { fprintf(stderr, "kernel_launch: launch %d failed: %s\n", ph, hipGetErrorName(le)); break; }
    }
#endif
}
```
